# Optimizing an MI355X kernel written in HIP

```python
import jax, jax.numpy as jnp
from jax import lax
import numpy as np

D_MODEL = 1024
BATCH = 8
SEQ = 4096
DEPTH = 1

PLE_DIM = 256
ATTN_HEADS = 8
ATTN_KV_HEADS = 2
ATTN_HEAD_DIM = 64
ATTN_GROUPS = ATTN_HEADS // ATTN_KV_HEADS
WINDOW = 128
ATTN_BLOCK = 128
ROPE_THETA = 10000.0
DN_HEADS = 4
DN_HEAD_DIM = 128
DN_CONV = 4
DN_CHUNK = 64
D_FF = 4 * D_MODEL
EPS = 1e-6

ATTN_Q = ATTN_HEADS * ATTN_HEAD_DIM
ATTN_KV = ATTN_KV_HEADS * ATTN_HEAD_DIM
DN_W = DN_HEADS * DN_HEAD_DIM
MIX_WIDTH = ATTN_Q + DN_W
SPLIT_SIZES = (ATTN_Q, ATTN_KV, ATTN_KV, DN_W, DN_W, DN_W, DN_W, DN_HEADS, DN_HEADS)
D_IN = sum(SPLIT_SIZES)
CONV_CH = 3 * DN_W

kernel_name = "hybrid_swa_sink_gated_deltanet_block"


def rmsnorm(x, g):
    xf = x.astype(jnp.float32)
    y = xf * lax.rsqrt(jnp.mean(xf * xf, axis=-1, keepdims=True) + EPS) * g.astype(jnp.float32)
    return y.astype(x.dtype)


def l2norm(x):
    return x * lax.rsqrt(jnp.sum(x * x, axis=-1, keepdims=True) + EPS)


def rope(t, positions):
    dh = t.shape[-1]
    half = dh // 2
    inv = 1.0 / (ROPE_THETA ** (jnp.arange(half, dtype=jnp.float32) * (2.0 / dh)))
    ang = positions.astype(jnp.float32)[:, None] * inv[None, :]
    cos = jnp.cos(ang)[None, :, None, :]
    sin = jnp.sin(ang)[None, :, None, :]
    tf = t.astype(jnp.float32)
    t1, t2 = tf[..., :half], tf[..., half:]
    out = jnp.concatenate([t1 * cos - t2 * sin, t2 * cos + t1 * sin], axis=-1)
    return out.astype(t.dtype)


def sliding_window_sink_attention(q, k, v, sinks):
    B, S = q.shape[0], q.shape[1]
    nb = S // ATTN_BLOCK
    qb = q.reshape(B, nb, ATTN_BLOCK, ATTN_KV_HEADS, ATTN_GROUPS, ATTN_HEAD_DIM)
    kb = k.reshape(B, nb, ATTN_BLOCK, ATTN_KV_HEADS, ATTN_HEAD_DIM)
    vb = v.reshape(B, nb, ATTN_BLOCK, ATTN_KV_HEADS, ATTN_HEAD_DIM)

    def with_prev(t):
        prev = jnp.concatenate([jnp.zeros_like(t[:, :1]), t[:, :-1]], axis=1)
        return jnp.concatenate([prev, t], axis=2)

    kw, vw = with_prev(kb), with_prev(vb)
    scale = ATTN_HEAD_DIM ** -0.5
    s = jnp.einsum('bnqhgd,bnkhd->bnhgqk', qb, kw).astype(jnp.float32) * scale
    blk = jnp.arange(nb)[:, None, None]
    qpos = blk * ATTN_BLOCK + jnp.arange(ATTN_BLOCK)[None, :, None]
    kpos = blk * ATTN_BLOCK - ATTN_BLOCK + jnp.arange(2 * ATTN_BLOCK)[None, None, :]
    valid = (kpos <= qpos) & (qpos - kpos < WINDOW) & (kpos >= 0)
    s = jnp.where(valid[:, None, None, :, :], s, -jnp.inf)
    sink = jnp.broadcast_to(
        sinks.astype(jnp.float32).reshape(1, 1, ATTN_KV_HEADS, ATTN_GROUPS, 1, 1),
        s.shape[:-1] + (1,))
    probs = jax.nn.softmax(jnp.concatenate([s, sink], axis=-1), axis=-1)[..., :-1]
    o = jnp.einsum('bnhgqk,bnkhd->bnqhgd', probs.astype(v.dtype), vw)
    return o.reshape(B, S, ATTN_Q)


def causal_conv(x, w):
    c = x.shape[-1]
    return lax.conv_general_dilated(
        x, w[:, None, :].astype(x.dtype), window_strides=(1,),
        padding=((DN_CONV - 1, 0),), dimension_numbers=('NWC', 'WIO', 'NWC'),
        feature_group_count=c)


def chunk_gated_delta_rule(q, k, v, g, beta):
    B, S, H, DK = q.shape
    DV = v.shape[-1]
    C = DN_CHUNK
    nc = S // C

    def to_chunks(t):
        t = jnp.moveaxis(t, 2, 1)
        return t.reshape(t.shape[:2] + (nc, C) + t.shape[3:])

    q, k, v, g, beta = (to_chunks(t) for t in (q, k, v, g, beta))
    g = jnp.cumsum(g, axis=-1)
    tril = jnp.tril(jnp.ones((C, C), dtype=bool))
    strict = jnp.tril(jnp.ones((C, C), dtype=bool), -1)
    decay = jnp.exp(jnp.where(tril, g[..., :, None] - g[..., None, :], -jnp.inf))
    k_beta = k * beta[..., None]
    v_beta = v * beta[..., None]
    L = jnp.where(strict, jnp.einsum('bhncd,bhnsd->bhncs', k_beta, k) * decay, 0.0)
    eye = jnp.eye(C, dtype=q.dtype)
    T = lax.linalg.triangular_solve(eye + L, jnp.broadcast_to(eye, L.shape),
                                    left_side=True, lower=True)
    u = jnp.einsum('bhncs,bhnsd->bhncd', T, v_beta)
    w = jnp.einsum('bhncs,bhnsd->bhncd', T, k_beta * jnp.exp(g)[..., None])
    a_qk = jnp.einsum('bhncd,bhnsd->bhncs', q, k) * decay
    q_g = q * jnp.exp(g)[..., None]
    g_last = g[..., -1]
    k_d = k * jnp.exp(g_last[..., None] - g)[..., None]
    d_last = jnp.exp(g_last)

    xs = tuple(jnp.moveaxis(t, 2, 0) for t in (q_g, k_d, u, w, a_qk, d_last))

    def step(state, inp):
        q_i, k_i, u_i, w_i, a_i, d_i = inp
        v_new = u_i - jnp.einsum('bhck,bhkv->bhcv', w_i, state)
        o = jnp.einsum('bhck,bhkv->bhcv', q_i, state) + jnp.einsum('bhcs,bhsv->bhcv', a_i, v_new)
        state = state * d_i[..., None, None] + jnp.einsum('bhck,bhcv->bhkv', k_i, v_new)
        return state, o

    s0 = jnp.zeros((B, H, DK, DV), dtype=q.dtype)
    _, o = lax.scan(step, s0, xs)
    o = jnp.moveaxis(o, 0, 2).reshape(B, H, S, DV)
    return jnp.moveaxis(o, 1, 2)


def gated_deltanet(q, k, v, z, b, a, conv_w, a_log, dt_bias, norm_w):
    B, S = q.shape[0], q.shape[1]
    qkv = jax.nn.silu(causal_conv(jnp.concatenate([q, k, v], axis=-1), conv_w))
    qc, kc, vc = jnp.split(qkv.astype(jnp.float32), 3, axis=-1)
    shp = (B, S, DN_HEADS, DN_HEAD_DIM)
    qc = l2norm(qc.reshape(shp)) * (DN_HEAD_DIM ** -0.5)
    kc = l2norm(kc.reshape(shp))
    vc = vc.reshape(shp)
    beta = jax.nn.sigmoid(b.astype(jnp.float32))
    g = -jnp.exp(a_log.astype(jnp.float32)) * jax.nn.softplus(
        a.astype(jnp.float32) + dt_bias.astype(jnp.float32))
    o = chunk_gated_delta_rule(qc, kc, vc, g, beta)
    o = o * lax.rsqrt(jnp.mean(o * o, axis=-1, keepdims=True) + EPS) * norm_w.astype(jnp.float32)
    o = o * jax.nn.silu(z.astype(jnp.float32).reshape(shp))
    return o.reshape(B, S, DN_W).astype(q.dtype)


def setup_inputs(seed: int = 0) -> dict:
    key = jax.random.key(seed)
    ks = jax.random.split(key, 20)
    f32 = jnp.float32
    nrm = lambda k, shape, s: jax.random.normal(k, shape, f32) * s
    gain = lambda k, shape: 1.0 + 0.02 * jax.random.normal(k, shape, f32)
    dt = jnp.exp(jax.random.uniform(ks[6], (DEPTH, DN_HEADS), f32, np.log(1e-3), np.log(1e-1)))
    return {
        "x": nrm(ks[0], (BATCH, SEQ, D_MODEL), 1.0),
        "p": nrm(ks[1], (DEPTH, BATCH, SEQ, PLE_DIM), 1.0),
        "norm_mix": gain(ks[2], (DEPTH, D_MODEL)),
        "w_in": nrm(ks[3], (DEPTH, D_MODEL, D_IN), D_MODEL ** -0.5),
        "conv_w": nrm(ks[4], (DEPTH, DN_CONV, CONV_CH), DN_CONV ** -0.5),
        "a_log": jnp.log(jax.random.uniform(ks[5], (DEPTH, DN_HEADS), f32, 1.0, 16.0)),
        "dt_bias": dt + jnp.log(-jnp.expm1(-dt)),
        "dn_norm": gain(ks[7], (DEPTH, DN_HEAD_DIM)),
        "sinks": nrm(ks[8], (DEPTH, ATTN_HEADS), 0.5),
        "w_o": nrm(ks[9], (DEPTH, MIX_WIDTH, D_MODEL), MIX_WIDTH ** -0.5),
        "norm_mlp": gain(ks[10], (DEPTH, D_MODEL)),
        "w_up": nrm(ks[11], (DEPTH, D_MODEL, D_FF), D_MODEL ** -0.5),
        "w_down": nrm(ks[12], (DEPTH, D_FF, D_MODEL), D_FF ** -0.5),
        "norm_ple": gain(ks[13], (DEPTH, D_MODEL)),
        "w_ple_gate": nrm(ks[14], (DEPTH, D_MODEL, D_MODEL), D_MODEL ** -0.5),
        "w_ple_proj": nrm(ks[15], (DEPTH, PLE_DIM, D_MODEL), PLE_DIM ** -0.5),
        "norm_final": gain(ks[16], (D_MODEL,)),
    }


def reference(x, p, norm_mix, w_in, conv_w, a_log, dt_bias, dn_norm, sinks, w_o,
              norm_mlp, w_up, w_down, norm_ple, w_ple_gate, w_ple_proj, norm_final):
    B, S, _ = x.shape
    positions = jnp.arange(S)
    split_idx = np.cumsum(SPLIT_SIZES)[:-1].tolist()
    h = x
    for i in range(DEPTH):
        u = rmsnorm(h, norm_mix[i])
        proj = u @ w_in[i]
        aq, ak, av, dq, dk, dv, dz, db, da = jnp.split(proj, split_idx, axis=-1)
        aq = rope(aq.reshape(B, S, ATTN_HEADS, ATTN_HEAD_DIM), positions)
        ak = rope(ak.reshape(B, S, ATTN_KV_HEADS, ATTN_HEAD_DIM), positions)
        av = av.reshape(B, S, ATTN_KV_HEADS, ATTN_HEAD_DIM)
        attn_out = sliding_window_sink_attention(aq, ak, av, sinks[i])
        dn_out = gated_deltanet(dq, dk, dv, dz, db, da, conv_w[i], a_log[i],
                                dt_bias[i], dn_norm[i])
        h = h + jnp.concatenate([attn_out, dn_out], axis=-1) @ w_o[i]
        m = rmsnorm(h, norm_mlp[i])
        h = h + jnp.square(jax.nn.relu(m @ w_up[i])) @ w_down[i]
        gate = jax.nn.sigmoid(rmsnorm(h, norm_ple[i]) @ w_ple_gate[i])
        h = h + gate * (p[i] @ w_ple_proj[i])
    return rmsnorm(h, norm_final)
```

```cpp
#include <hip/hip_runtime.h>
#include <cstdio>
#include <cstdint>

namespace nv {
constexpr int D = 1024, S = 4096, NB = 8, DIN = 2824, FF = 4096, PLE = 256;
constexpr int O_AQ = 0, O_AK = 512, O_AV = 640, O_DQ = 768, O_DK = 1280, O_DV = 1792, O_DZ = 2304, O_DB = 2816, O_DA = 2820;
constexpr float EPS = 1e-6f;

__device__ __forceinline__ float wave_sum(float v) {
#pragma unroll
    for (int o = 1; o < 64; o <<= 1) v += __shfl_xor(v, o);
    return v;
}
__global__ void __launch_bounds__(256) k_rowstat(const float* X, float* r, int rows) {
    const int w = (blockIdx.x * 256 + threadIdx.x) >> 6, lane = threadIdx.x & 63;
    if (w >= rows) return;
    const float4* x = (const float4*)(X + (size_t)w * D);
    float s = 0.f;
#pragma unroll
    for (int j = 0; j < 4; ++j) { float4 v = x[lane + 64 * j]; s += v.x * v.x + v.y * v.y + v.z * v.z + v.w * v.w; }
    s = wave_sum(s);
    if (lane == 0) r[w] = rsqrtf(s * (1.f / D) + EPS);
}
template <int EPI>
__global__ void __launch_bounds__(256) k_gemm(const float* A, int lda, const float* gain, const float* rs, const float* W, int ldw, int N, int K,
                                              const float* R, int ldr, float* C, int ldc) {
    __shared__ float As[16][68];
    __shared__ float Ws[16][68];
    const int tx = threadIdx.x & 15, ty = threadIdx.x >> 4;
    const int row0 = blockIdx.y * 64, col0 = blockIdx.x * 64;
    float acc[4][4];
#pragma unroll
    for (int i = 0; i < 4; ++i)
#pragma unroll
        for (int j = 0; j < 4; ++j) acc[i][j] = 0.f;
    for (int k0 = 0; k0 < K; k0 += 16) {
#pragma unroll
        for (int i = 0; i < 4; ++i) {
            const int idx = threadIdx.x + i * 256;
            { const int r = idx >> 4, kk = idx & 15; float a = A[(size_t)(row0 + r) * lda + k0 + kk]; if (gain) a *= gain[k0 + kk]; As[kk][r] = a; }
            { const int kk = idx >> 6, c = idx & 63; Ws[kk][c] = (col0 + c < N) ? W[(size_t)(k0 + kk) * ldw + col0 + c] : 0.f; }
        }
        __syncthreads();
#pragma unroll
        for (int kk = 0; kk < 16; ++kk) {
            float a[4], b[4];
#pragma unroll
            for (int i = 0; i < 4; ++i) { a[i] = As[kk][ty * 4 + i]; b[i] = Ws[kk][tx * 4 + i]; }
#pragma unroll
            for (int i = 0; i < 4; ++i)
#pragma unroll
                for (int j = 0; j < 4; ++j) acc[i][j] = fmaf(a[i], b[j], acc[i][j]);
        }
        __syncthreads();
    }
#pragma unroll
    for (int i = 0; i < 4; ++i) {
        const int row = row0 + ty * 4 + i; const float sc = rs ? rs[row] : 1.f;
#pragma unroll
        for (int j = 0; j < 4; ++j) {
            const int col = col0 + tx * 4 + j; if (col >= N) continue;
            float v = acc[i][j] * sc;
            if (EPI == 1) { v = v > 0.f ? v * v : 0.f; }
            if (EPI == 2) { v = 1.f / (1.f + expf(-v)); }
            if (R) v += R[(size_t)row * ldr + col];
            C[(size_t)row * ldc + col] = v;
        }
    }
}
__global__ void __launch_bounds__(256) k_rope(float* proj, int rows) {
    const int idx = blockIdx.x * 256 + threadIdx.x; if (idx >= rows * 10 * 32) return;
    const int j = idx & 31, hh = (idx >> 5) % 10, t = idx / 320;
    float* p = proj + (size_t)t * DIN + hh * 64;
    const float inv = 1.0f / powf(10000.0f, (float)j * (2.0f / 64.0f));
    const float ang = (float)t * inv;
    const float c = cosf(ang), s = sinf(ang);
    const float x1 = p[j], x2 = p[j + 32];
    p[j] = x1 * c - x2 * s; p[j + 32] = x2 * c + x1 * s;
}
__global__ void __launch_bounds__(128) k_attn(const float* proj, const float* sinks, float* mix, int rows) {
    const int t = blockIdx.x * 128 + threadIdx.x, h = blockIdx.y; if (t >= rows) return;
    const int kvh = h >> 2;
    float q[64], o[64];
    const float* qp = proj + (size_t)t * DIN + O_AQ + h * 64;
#pragma unroll
    for (int d = 0; d < 64; ++d) { q[d] = qp[d] * 0.125f; o[d] = 0.f; }
    float m = -INFINITY, l = 0.f;
    const int k0 = t - 127 > 0 ? t - 127 : 0;
    for (int kp = k0; kp <= t; ++kp) {
        const float* kr = proj + (size_t)kp * DIN + O_AK + kvh * 64;
        const float* vr = proj + (size_t)kp * DIN + O_AV + kvh * 64;
        float s = 0.f;
#pragma unroll
        for (int d = 0; d < 64; ++d) s = fmaf(q[d], kr[d], s);
        const float mn = fmaxf(m, s), f = expf(m - mn), pe = expf(s - mn);
        l = l * f + pe;
#pragma unroll
        for (int d = 0; d < 64; ++d) o[d] = o[d] * f + pe * vr[d];
        m = mn;
    }
    const float sk = sinks[h];
    const float mn = fmaxf(m, sk), f = expf(m - mn);
    l = l * f + expf(sk - mn);
    const float il = f / l;
    float* op = mix + (size_t)t * D + h * 64;
#pragma unroll
    for (int d = 0; d < 64; ++d) op[d] = o[d] * il;
}
__global__ void __launch_bounds__(128) k_dnprep(const float* proj, const float* conv_w, const float* a_log, const float* dt_bias,
                                                 float* qn, float* kn, float* vc, float* bg, int rows) {
    __shared__ float red[4];
    const int t = blockIdx.x, h = blockIdx.y, d = threadIdx.x, c = h * 128 + d;
    float xq = 0.f, xk = 0.f, xv = 0.f;
#pragma unroll
    for (int j = 0; j < 4; ++j) {
        const int tt = t - 3 + j; if (tt < 0) continue;
        const float* pr = proj + (size_t)tt * DIN;
        xq = fmaf(conv_w[j * 1536 + c], pr[O_DQ + c], xq);
        xk = fmaf(conv_w[j * 1536 + 512 + c], pr[O_DK + c], xk);
        xv = fmaf(conv_w[j * 1536 + 1024 + c], pr[O_DV + c], xv);
    }
    xq = xq / (1.f + expf(-xq)); xk = xk / (1.f + expf(-xk)); xv = xv / (1.f + expf(-xv));
    float sq = wave_sum(xq * xq), sk = wave_sum(xk * xk);
    if ((d & 63) == 0) { red[(d >> 6) * 2] = sq; red[(d >> 6) * 2 + 1] = sk; }
    __syncthreads();
    sq = red[0] + red[2]; sk = red[1] + red[3];
    qn[(size_t)t * 512 + c] = xq * rsqrtf(sq + EPS) * 0.08838834764831845f;
    kn[(size_t)t * 512 + c] = xk * rsqrtf(sk + EPS);
    vc[(size_t)t * 512 + c] = xv;
    if (d == 0) {
        const float* pr = proj + (size_t)t * DIN;
        const float b = pr[O_DB + h], a = pr[O_DA + h] + dt_bias[h];
        const float sp = a > 20.f ? a : log1pf(expf(a));
        bg[(size_t)t * 8 + h] = 1.f / (1.f + expf(-b));
        bg[(size_t)t * 8 + 4 + h] = -expf(a_log[h]) * sp;
    }
}
__global__ void __launch_bounds__(64) k_dnrec(const float* qn, const float* kn, const float* vc, const float* bg, float* odn, int rows) {
    const int h = blockIdx.y, j = blockIdx.x * 64 + threadIdx.x;
    float St[128];
#pragma unroll
    for (int i = 0; i < 128; ++i) St[i] = 0.f;
    for (int t = 0; t < rows; ++t) {
        const float4* kr = (const float4*)(kn + (size_t)t * 512 + h * 128);
        const float4* qr = (const float4*)(qn + (size_t)t * 512 + h * 128);
        const float eg = expf(bg[(size_t)t * 8 + 4 + h]), beta = bg[(size_t)t * 8 + h];
        const float v = vc[(size_t)t * 512 + h * 128 + j];
        float d0 = 0.f, d1 = 0.f, d2 = 0.f, d3 = 0.f;
#pragma unroll
        for (int i = 0; i < 32; ++i) { const float4 kk = kr[i];
            St[4 * i] *= eg; St[4 * i + 1] *= eg; St[4 * i + 2] *= eg; St[4 * i + 3] *= eg;
            d0 = fmaf(St[4 * i], kk.x, d0); d1 = fmaf(St[4 * i + 1], kk.y, d1); d2 = fmaf(St[4 * i + 2], kk.z, d2); d3 = fmaf(St[4 * i + 3], kk.w, d3); }
        const float vn = beta * (v - ((d0 + d1) + (d2 + d3)));
        float o0 = 0.f, o1 = 0.f, o2 = 0.f, o3 = 0.f;
#pragma unroll
        for (int i = 0; i < 32; ++i) { const float4 kk = kr[i]; const float4 qq = qr[i];
            St[4 * i] = fmaf(kk.x, vn, St[4 * i]); St[4 * i + 1] = fmaf(kk.y, vn, St[4 * i + 1]); St[4 * i + 2] = fmaf(kk.z, vn, St[4 * i + 2]); St[4 * i + 3] = fmaf(kk.w, vn, St[4 * i + 3]);
            o0 = fmaf(St[4 * i], qq.x, o0); o1 = fmaf(St[4 * i + 1], qq.y, o1); o2 = fmaf(St[4 * i + 2], qq.z, o2); o3 = fmaf(St[4 * i + 3], qq.w, o3); }
        odn[(size_t)t * 512 + h * 128 + j] = (o0 + o1) + (o2 + o3);
    }
}
__global__ void __launch_bounds__(128) k_dnout(const float* odn, const float* proj, const float* dn_norm, float* mix) {
    __shared__ float red[2];
    const int t = blockIdx.x, h = blockIdx.y, d = threadIdx.x;
    const float o = odn[(size_t)t * 512 + h * 128 + d];
    float s = wave_sum(o * o);
    if ((d & 63) == 0) red[d >> 6] = s;
    __syncthreads();
    s = red[0] + red[1];
    const float z = proj[(size_t)t * DIN + O_DZ + h * 128 + d];
    mix[(size_t)t * D + 512 + h * 128 + d] = o * rsqrtf(s * (1.f / 128.f) + EPS) * dn_norm[d] * (z / (1.f + expf(-z)));
}
__global__ void __launch_bounds__(256) k_final(const float* h2, const float* G, const float* PP, const float* g, float* out, int rows) {
    const int w = (blockIdx.x * 256 + threadIdx.x) >> 6, lane = threadIdx.x & 63;
    if (w >= rows) return;
    const float4* a = (const float4*)(h2 + (size_t)w * D); const float4* b = (const float4*)(G + (size_t)w * D); const float4* c = (const float4*)(PP + (size_t)w * D);
    float4 v[4]; float s = 0.f;
#pragma unroll
    for (int j = 0; j < 4; ++j) { const float4 x = a[lane + 64 * j], y = b[lane + 64 * j], z = c[lane + 64 * j];
        v[j].x = x.x + y.x * z.x; v[j].y = x.y + y.y * z.y; v[j].z = x.z + y.z * z.z; v[j].w = x.w + y.w * z.w;
        s += v[j].x * v[j].x + v[j].y * v[j].y + v[j].z * v[j].z + v[j].w * v[j].w; }
    s = wave_sum(s);
    const float r = rsqrtf(s * (1.f / D) + EPS);
    float4* o = (float4*)(out + (size_t)w * D); const float4* gg = (const float4*)g;
#pragma unroll
    for (int j = 0; j < 4; ++j) { const float4 q = gg[lane + 64 * j]; float4 y; y.x = v[j].x * r * q.x; y.y = v[j].y * r * q.y; y.z = v[j].z * r * q.z; y.w = v[j].w * r * q.w; o[lane + 64 * j] = y; }
}
}

extern "C" void kernel_launch(void* const* d_in, const int* in_sizes, int n_in, void* d_out, int out_size, void* d_ws, size_t ws_size, hipStream_t stream) {
    using namespace nv;
    const float* x = (const float*)d_in[0]; const float* p = (const float*)d_in[1]; const float* norm_mix = (const float*)d_in[2]; const float* w_in = (const float*)d_in[3];
    const float* conv_w = (const float*)d_in[4]; const float* a_log = (const float*)d_in[5]; const float* dt_bias = (const float*)d_in[6]; const float* dn_norm = (const float*)d_in[7];
    const float* sinks = (const float*)d_in[8]; const float* w_o = (const float*)d_in[9]; const float* norm_mlp = (const float*)d_in[10]; const float* w_up = (const float*)d_in[11];
    const float* w_down = (const float*)d_in[12]; const float* norm_ple = (const float*)d_in[13]; const float* w_gate = (const float*)d_in[14]; const float* w_proj = (const float*)d_in[15];
    const float* norm_final = (const float*)d_in[16];
    float* out = (float*)d_out;
    float* ws = (float*)d_ws; size_t off = 0;
    auto take = [&](size_t n) { float* r = ws + off; off += (n + 63) & ~(size_t)63; return r; };
    const int Tb = S;
    float* proj = take((size_t)Tb * DIN); float* r0 = take(Tb); float* r1 = take(Tb); float* r2 = take(Tb);
    float* qn = take((size_t)Tb * 512); float* kn = take((size_t)Tb * 512); float* vc = take((size_t)Tb * 512); float* bg = take((size_t)Tb * 8);
    float* odn = take((size_t)Tb * 512); float* mix = take((size_t)Tb * D); float* h1 = take((size_t)Tb * D); float* hid = take((size_t)Tb * FF);
    float* h2 = take((size_t)Tb * D); float* G = take((size_t)Tb * D); float* PP = take((size_t)Tb * D);
    for (int b = 0; b < NB; ++b) {
        const float* xb = x + (size_t)b * Tb * D; const float* pb = p + (size_t)b * Tb * PLE; float* ob = out + (size_t)b * Tb * D;
        k_rowstat<<<Tb / 4, 256, 0, stream>>>(xb, r0, Tb);
        k_gemm<0><<<dim3((DIN + 63) / 64, Tb / 64), 256, 0, stream>>>(xb, D, norm_mix, r0, w_in, DIN, DIN, D, nullptr, 0, proj, DIN);
        k_rope<<<(Tb * 320 + 255) / 256, 256, 0, stream>>>(proj, Tb);
        k_attn<<<dim3(Tb / 128, 8), 128, 0, stream>>>(proj, sinks, mix, Tb);
        k_dnprep<<<dim3(Tb, 4), 128, 0, stream>>>(proj, conv_w, a_log, dt_bias, qn, kn, vc, bg, Tb);
        k_dnrec<<<dim3(2, 4), 64, 0, stream>>>(qn, kn, vc, bg, odn, Tb);
        k_dnout<<<dim3(Tb, 4), 128, 0, stream>>>(odn, proj, dn_norm, mix);
        k_gemm<0><<<dim3(D / 64, Tb / 64), 256, 0, stream>>>(mix, D, nullptr, nullptr, w_o, D, D, D, xb, D, h1, D);
        k_rowstat<<<Tb / 4, 256, 0, stream>>>(h1, r1, Tb);
        k_gemm<1><<<dim3(FF / 64, Tb / 64), 256, 0, stream>>>(h1, D, norm_mlp, r1, w_up, FF, FF, D, nullptr, 0, hid, FF);
        k_gemm<0><<<dim3(D / 64, Tb / 64), 256, 0, stream>>>(hid, FF, nullptr, nullptr, w_down, D, D, FF, h1, D, h2, D);
        k_rowstat<<<Tb / 4, 256, 0, stream>>>(h2, r2, Tb);
        k_gemm<2><<<dim3(D / 64, Tb / 64), 256, 0, stream>>>(h2, D, norm_ple, r2, w_gate, D, D, D, nullptr, 0, G, D);
        k_gemm<0><<<dim3(D / 64, Tb / 64), 256, 0, stream>>>(pb, PLE, nullptr, nullptr, w_proj, D, D, PLE, nullptr, 0, PP, D);
        k_final<<<Tb / 4, 256, 0, stream>>>(h2, G, PP, norm_final, ob, Tb);
    }
}
```

```cpp
#include <hip/hip_runtime.h>
#include <cstdio>
#include <cstdint>
__device__ __forceinline__ int hw_lane() { int l = __builtin_amdgcn_mbcnt_hi(~0u, __builtin_amdgcn_mbcnt_lo(~0u, 0u)); asm volatile("" : "+v"(l)); return l; }
namespace pg8 {
#define PG8_LAS __attribute__((address_space(3)))
typedef unsigned short bf16_t;
typedef short bf16x8 __attribute__((ext_vector_type(8)));
typedef float f32x4 __attribute__((ext_vector_type(4)));
typedef unsigned u32x4 __attribute__((ext_vector_type(4)));
constexpr int BM = 256, BK = 64, HALF = 128, HTB = HALF * BK * 2  , STAGE_BYTES = 8 * HTB, NXCD = 8, WGM = 8;

__host__ __device__ __forceinline__ int lds_byte(int r, int c) { const int st = (r >> 4) * 2 + (c >> 5), rr = r & 15, cc = c & 31, ob = rr * 64 + cc * 2; return st * 1024 + (ob ^ (((ob >> 9) & 1) << 5)); }
__host__ __device__ __forceinline__ void stage_rc(int b, int& R, int& C) { const int st = b / 1024, sb = b % 1024, swz = sb ^ (((sb >> 9) & 1) << 5); R = (st >> 1) * 16 + swz / 64; C = (st & 1) * 32 + (swz % 64) / 2; }
__host__ __device__ __forceinline__ int perm32(int rho) { const int n = rho >> 4, i = rho & 15; return 8 * (i >> 2) + 4 * n + (i & 3); }

struct Unit { int pm, pn; };
struct Gemm { const bf16_t* A; const bf16_t* Bt; int M, N, K; };

struct StaticOrder {
    int nM, nN, nwg, G, c;
    __host__ __device__ void init(int M, int N, int G_, int c_) { nM = M / BM; nN = N / BM; nwg = nM * nN; G = G_; c = c_; }
    __host__ __device__ bool next(int i, Unit& u) const {
        const long L = (long)i * G + c; if (L >= nwg) return false;
        int wgid = (int)L; { const int q = nwg / NXCD, r = nwg % NXCD, xcd = wgid % NXCD, off = wgid / NXCD; wgid = (xcd < r ? xcd * (q + 1) : r * (q + 1) + (xcd - r) * q) + off; }
        const int nig = WGM * nN, gid = wgid / nig, fm = gid * WGM, gsz = (nM - fm) < WGM ? (nM - fm) : WGM;
        u.pm = fm + ((wgid % nig) % gsz); u.pn = (wgid % nig) / gsz; return true;
    }
    __device__ __forceinline__ void a_ready(const Unit&) const {}
    __device__ __forceinline__ void done(const Unit&) const {}
};

__device__ __forceinline__ unsigned cvt_pk_bf16(float lo, float hi) { unsigned r; asm volatile("v_cvt_pk_bf16_f32 %0, %1, %2" : "=v"(r) : "v"(lo), "v"(hi)); return r; }
typedef unsigned u32x2 __attribute__((ext_vector_type(2)));
constexpr float RMS_EPS = 1e-6f;
constexpr float QSCALE = 0.125f * 1.4426950408889634f;
struct EpiProj {
    static constexpr bool PERM = true, AFTER_DRAIN = false;
    bf16_t* O; const float* r0; const float* cs; const float* sn;
    __device__ __forceinline__ void operator()(const f32x4 (&acc)[2][2][4][2], const Unit& u, int wr, int wc, int fr, int fq) const {
        const int row0 = u.pm * BM + wr * 64 + fr, ct = u.pn * BM;
        const int i4 = ((wc & 1) * 4 + fq) * 4;
#pragma unroll
        for (int ai = 0; ai < 2; ++ai)
#pragma unroll
            for (int m = 0; m < 4; ++m) {
                const int row = row0 + ai * HALF + m * 16; const float rs = r0[row]; const int pos = row & 4095;
                f32x4 c4 = (f32x4){1.f, 1.f, 1.f, 1.f}, s4 = (f32x4){0.f, 0.f, 0.f, 0.f};
                if (ct < 768) { c4 = *(const f32x4*)(cs + pos * 32 + i4); s4 = *(const f32x4*)(sn + pos * 32 + i4); }
                bf16_t* rowp = O + (size_t)row * 2816;
#pragma unroll
                for (int bj = 0; bj < 2; ++bj) {
                    const int cwu = ct + bj * HALF + wc * 32;
                    const f32x4 v0 = acc[ai][bj][m][0] * rs, v1 = acc[ai][bj][m][1] * rs;
                    if (cwu < 640) {
                        f32x4 o1 = v0 * c4 - v1 * s4, o2 = v1 * c4 + v0 * s4;
                        if (cwu < 512) { o1 = o1 * QSCALE; o2 = o2 * QSCALE; }
                        const int hb = cwu & ~63; u32x2 w1, w2;
                        w1.x = cvt_pk_bf16(o1[0], o1[1]); w1.y = cvt_pk_bf16(o1[2], o1[3]); w2.x = cvt_pk_bf16(o2[0], o2[1]); w2.y = cvt_pk_bf16(o2[2], o2[3]);
                        *(u32x2*)(rowp + hb + i4) = w1; *(u32x2*)(rowp + hb + 32 + i4) = w2;
                    } else {
                        u32x4 w; w.x = cvt_pk_bf16(v0[0], v0[1]); w.y = cvt_pk_bf16(v0[2], v0[3]); w.z = cvt_pk_bf16(v1[0], v1[1]); w.w = cvt_pk_bf16(v1[2], v1[3]);
                        *(u32x4*)(rowp + cwu + 8 * fq) = w;
                    }
                }
            }
    }
};
template <int ACT> struct EpiAct {
    static constexpr bool PERM = true, AFTER_DRAIN = false;
    bf16_t* O; int ldc; const float* ssq;
    __device__ __forceinline__ void operator()(const f32x4 (&acc)[2][2][4][2], const Unit& u, int wr, int wc, int fr, int fq) const {
        const int row0 = u.pm * BM + wr * 64 + fr, col0 = u.pn * BM + wc * 32 + 8 * fq;
#pragma unroll
        for (int ai = 0; ai < 2; ++ai)
#pragma unroll
            for (int m = 0; m < 4; ++m) {
                const int row = row0 + ai * HALF + m * 16; float rs = 1.f;
                if (ACT == 1) rs = __builtin_amdgcn_rsqf(ssq[row] * (1.f / 1024.f) + RMS_EPS);
                bf16_t* rowp = O + (size_t)row * ldc + col0;
#pragma unroll
                for (int bj = 0; bj < 2; ++bj) {
                    f32x4 v0 = acc[ai][bj][m][0], v1 = acc[ai][bj][m][1];
                    if (ACT == 1) {
                        v0 = v0 * rs; v1 = v1 * rs;
#pragma unroll
                        for (int e = 0; e < 4; ++e) { const float a = fmaxf(v0[e], 0.f), b = fmaxf(v1[e], 0.f); v0[e] = a * a; v1[e] = b * b; }
                    }
                    u32x4 w; w.x = cvt_pk_bf16(v0[0], v0[1]); w.y = cvt_pk_bf16(v0[2], v0[3]); w.z = cvt_pk_bf16(v1[0], v1[1]); w.w = cvt_pk_bf16(v1[2], v1[3]);
                    *(u32x4*)(rowp + bj * HALF) = w;
                }
            }
    }
};
struct EpiRes {
    static constexpr bool PERM = false, AFTER_DRAIN = false;
    const float* base; float* out; bf16_t* hb; float* ssq;
    __device__ __forceinline__ void operator()(const f32x4 (&acc)[2][2][4][2], const Unit& u, int wr, int wc, int fr, int fq) const {
        const int row0 = u.pm * BM + wr * 64 + fr, col0 = u.pn * BM + wc * 32 + 4 * fq;
#pragma unroll
        for (int ai = 0; ai < 2; ++ai)
#pragma unroll
            for (int m = 0; m < 4; ++m) {
                const int row = row0 + ai * HALF + m * 16; const size_t off = (size_t)row * 1024 + col0; float sq = 0.f;
#pragma unroll
                for (int bj = 0; bj < 2; ++bj)
#pragma unroll
                    for (int n = 0; n < 2; ++n) {
                        const f32x4 v = *(const f32x4*)(base + off + bj * HALF + n * 16) + acc[ai][bj][m][n];
                        *(f32x4*)(out + off + bj * HALF + n * 16) = v;
                        u32x2 w; w.x = cvt_pk_bf16(v[0], v[1]); w.y = cvt_pk_bf16(v[2], v[3]); *(u32x2*)(hb + off + bj * HALF + n * 16) = w;
                        sq += (v[0] * v[0] + v[1] * v[1]) + (v[2] * v[2] + v[3] * v[3]);
                    }
                sq += __shfl_xor(sq, 16); sq += __shfl_xor(sq, 32);
                if (fq == 0) atomicAdd(ssq + row, sq);
            }
    }
};
struct EpiGate {
    static constexpr bool PERM = false, AFTER_DRAIN = false;
    float* out; const bf16_t* pp; const float* ssq2; float* ssq3;
    __device__ __forceinline__ void operator()(const f32x4 (&acc)[2][2][4][2], const Unit& u, int wr, int wc, int fr, int fq) const {
        const int row0 = u.pm * BM + wr * 64 + fr, col0 = u.pn * BM + wc * 32 + 4 * fq;
#pragma unroll
        for (int ai = 0; ai < 2; ++ai)
#pragma unroll
            for (int m = 0; m < 4; ++m) {
                const int row = row0 + ai * HALF + m * 16; const size_t off = (size_t)row * 1024 + col0; float sq = 0.f;
                const float rs = __builtin_amdgcn_rsqf(ssq2[row] * (1.f / 1024.f) + RMS_EPS);
#pragma unroll
                for (int bj = 0; bj < 2; ++bj)
#pragma unroll
                    for (int n = 0; n < 2; ++n) {
                        const f32x4 h2 = *(const f32x4*)(out + off + bj * HALF + n * 16);
                        const u32x2 pw = *(const u32x2*)(pp + off + bj * HALF + n * 16);
                        f32x4 p; p[0] = __uint_as_float(pw.x << 16); p[1] = __uint_as_float(pw.x & 0xffff0000u); p[2] = __uint_as_float(pw.y << 16); p[3] = __uint_as_float(pw.y & 0xffff0000u);
                        f32x4 v;
#pragma unroll
                        for (int e = 0; e < 4; ++e) { const float g = 1.f / (1.f + __expf(-acc[ai][bj][m][n][e] * rs)); v[e] = h2[e] + g * p[e]; }
                        *(f32x4*)(out + off + bj * HALF + n * 16) = v;
                        sq += (v[0] * v[0] + v[1] * v[1]) + (v[2] * v[2] + v[3] * v[3]);
                    }
                sq += __shfl_xor(sq, 16); sq += __shfl_xor(sq, 32);
                if (fq == 0) atomicAdd(ssq3 + row, sq);
            }
    }
};
template <class Epi, class Sched, bool ALIGN_EPI = false, bool SP2 = false>
__device__ __forceinline__ void gemm_phase(PG8_LAS unsigned char* lds, const Gemm g, const Sched& S, const Epi& E, int wid_in) {
    const int wid = __builtin_amdgcn_readfirstlane(wid_in), lane = hw_lane(), tid = wid * 64 + lane, wr = wid >> 2, wc = wid & 3, fr = lane & 15, fq = lane >> 4;
    const int K = g.K, nt = K / BK;
    unsigned voffA[2], voffB[2];
#pragma unroll
    for (int i = 0; i < 2; ++i) { int R, C; stage_rc(tid * 16 + i * 8192, R, C); const int Rb = Epi::PERM ? ((R & ~31) + perm32(R & 31)) : R;
        voffA[i] = (unsigned)(R * K + C) * 2u; voffB[i] = (unsigned)(Rb * K + C) * 2u; }
    const size_t kstep = (size_t)(BK * 2);
    const size_t hstep = (size_t)HALF * K * 2;
    const size_t tstep = 2 * hstep;
    const unsigned ldsw = (unsigned)wid * 1024u;
    const int aoff = lds_byte(wr * 64 + fr, fq * 8), boff = lds_byte(wc * 32 + fr, fq * 8);
#define PG8_SA(b, h) (((b) * 2 + (h)) * HTB)
#define PG8_SB(b, h) ((4 + (b) * 2 + (h)) * HTB)
#define PG8_STAGE(bufoff, gbase, voff) do { _Pragma("unroll") for (int _i = 0; _i < 2; ++_i) \
        __builtin_amdgcn_global_load_lds((const unsigned*)((const char*)(gbase) + (voff)[_i]), (PG8_LAS unsigned*)(lds + (bufoff) + ldsw + _i * 8192), 16, 0, 0); } while (0)
#define PG8_LDA(dst, b, h) do { _Pragma("unroll") for (int m = 0; m < 4; ++m) _Pragma("unroll") for (int k = 0; k < 2; ++k) dst[m][k] = *(const PG8_LAS bf16x8*)(lds + PG8_SA(b, h) + aoff + m * 2048 + k * 1024); } while (0)
#define PG8_LDB(dst, b, h) do { _Pragma("unroll") for (int n = 0; n < 2; ++n) _Pragma("unroll") for (int k = 0; k < 2; ++k) dst[n][k] = *(const PG8_LAS bf16x8*)(lds + PG8_SB(b, h) + boff + n * 2048 + k * 1024); } while (0)
#define PG8_MMA(ai, bj, At, Bt) do { __builtin_amdgcn_s_setprio(1); _Pragma("unroll") for (int m = 0; m < 4; ++m) _Pragma("unroll") for (int n = 0; n < 2; ++n) _Pragma("unroll") for (int k = 0; k < 2; ++k) \
        acc[ai][bj][m][n] = __builtin_amdgcn_mfma_f32_16x16x32_bf16(Bt[n][k], At[m][k], acc[ai][bj][m][n], 0, 0, 0); __builtin_amdgcn_s_setprio(0); } while (0)
#define PG8_WAIT_V(n) asm volatile("s_waitcnt vmcnt(" #n ")" ::: "memory")
#define PG8_WAIT_L(n) asm volatile("s_waitcnt lgkmcnt(" #n ")" ::: "memory")
#define PG8_BAR __builtin_amdgcn_s_barrier()
#define PG8_SCHED __builtin_amdgcn_sched_barrier(0)
    Unit cur, nxt; int ui = 0;
    if (!S.next(0, cur)) return;
    f32x4 acc[2][2][4][2];
#pragma unroll
    for (int a = 0; a < 2; ++a)
#pragma unroll
        for (int b = 0; b < 2; ++b)
#pragma unroll
            for (int m = 0; m < 4; ++m)
#pragma unroll
                for (int n = 0; n < 2; ++n) acc[a][b][m][n] = (f32x4){0.f, 0.f, 0.f, 0.f};
    bf16x8 At[4][2], B0[2][2], B1[2][2];
    const char* cA = (const char*)g.A + (size_t)cur.pm * tstep; const char* cB = (const char*)g.Bt + (size_t)cur.pn * tstep;
    S.a_ready(cur);
    if constexpr (SP2) {
        PG8_STAGE(PG8_SB(0, 0), cB, voffB); PG8_STAGE(PG8_SB(0, 1), cB + hstep, voffB); PG8_STAGE(PG8_SA(0, 0), cA, voffA); PG8_STAGE(PG8_SA(0, 1), cA + hstep, voffA);
        if (wr == 1) PG8_BAR;
        PG8_WAIT_V(2); PG8_BAR;
        PG8_STAGE(PG8_SB(1, 0), cB + kstep, voffB); PG8_STAGE(PG8_SA(1, 0), cA + kstep, voffA); PG8_STAGE(PG8_SB(1, 1), cB + hstep + kstep, voffB);
        PG8_WAIT_V(6); PG8_BAR;
    } else {
        PG8_STAGE(PG8_SB(0, 0), cB, voffB); PG8_STAGE(PG8_SA(0, 0), cA, voffA); PG8_STAGE(PG8_SB(0, 1), cB + hstep, voffB); PG8_STAGE(PG8_SA(0, 1), cA + hstep, voffA);
        if (wr == 1) PG8_BAR;
        PG8_WAIT_V(4); PG8_BAR;
        PG8_STAGE(PG8_SB(1, 0), cB + kstep, voffB); PG8_STAGE(PG8_SA(1, 0), cA + kstep, voffA); PG8_STAGE(PG8_SB(1, 1), cB + hstep + kstep, voffB);
        PG8_WAIT_V(6); PG8_BAR;
    }
    for (;;) {
        const bool has_next = S.next(ui + 1, nxt);
        const char* nA = has_next ? (const char*)g.A + (size_t)nxt.pm * tstep : cA; const char* nB = has_next ? (const char*)g.Bt + (size_t)nxt.pn * tstep : cB;
        for (int t = 0; t < nt; t += 2) {
            const bool last = (t == nt - 2);
            const char* a1 = cA + (size_t)(t + 1) * kstep;
            const char* a2 = last ? nA : cA + (size_t)(t + 2) * kstep; const char* b2 = last ? nB : cB + (size_t)(t + 2) * kstep;
            const char* a3 = a2 + kstep; const char* b3 = b2 + kstep;
            if (last && has_next) S.a_ready(nxt);
            if constexpr (SP2) {
            PG8_LDB(B0, 0, 0); PG8_LDB(B1, 0, 1); PG8_SCHED; PG8_LDA(At, 0, 0); PG8_STAGE(PG8_SA(1, 1), a1 + hstep, voffA);
            PG8_WAIT_V(8); PG8_WAIT_L(0); PG8_BAR; PG8_MMA(0, 0, At, B0); PG8_MMA(0, 1, At, B1); PG8_BAR; PG8_SCHED;
            PG8_LDA(At, 0, 1); PG8_STAGE(PG8_SB(0, 0), b2, voffB); PG8_STAGE(PG8_SB(0, 1), b2 + hstep, voffB); PG8_STAGE(PG8_SA(0, 0), a2, voffA);
            PG8_WAIT_V(8); PG8_WAIT_L(0); PG8_BAR; PG8_MMA(1, 0, At, B0); PG8_MMA(1, 1, At, B1); PG8_BAR; PG8_SCHED;
            PG8_LDB(B0, 1, 0); PG8_LDB(B1, 1, 1); PG8_SCHED; PG8_LDA(At, 1, 0); PG8_STAGE(PG8_SA(0, 1), a2 + hstep, voffA);
            PG8_WAIT_V(8); PG8_WAIT_L(0); PG8_BAR; PG8_MMA(0, 0, At, B0); PG8_MMA(0, 1, At, B1); PG8_BAR; PG8_SCHED;
            PG8_LDA(At, 1, 1); PG8_STAGE(PG8_SB(1, 0), b3, voffB); PG8_STAGE(PG8_SB(1, 1), b3 + hstep, voffB); PG8_STAGE(PG8_SA(1, 0), a3, voffA);
            PG8_WAIT_V(8); PG8_WAIT_L(0); PG8_BAR; PG8_MMA(1, 0, At, B0); PG8_MMA(1, 1, At, B1); PG8_BAR; PG8_SCHED;
            } else {
            PG8_LDB(B0, 0, 0); PG8_SCHED; PG8_LDA(At, 0, 0); PG8_STAGE(PG8_SA(1, 1), a1 + hstep, voffA);
            PG8_WAIT_L(8); PG8_BAR; PG8_WAIT_L(0); PG8_MMA(0, 0, At, B0); PG8_BAR; PG8_SCHED;
            PG8_LDB(B1, 0, 1); PG8_STAGE(PG8_SB(0, 0), b2, voffB);
            PG8_BAR; PG8_WAIT_L(0); PG8_MMA(0, 1, At, B1); PG8_BAR;
            PG8_LDA(At, 0, 1); PG8_STAGE(PG8_SA(0, 0), a2, voffA);
            PG8_BAR; PG8_WAIT_L(0); PG8_MMA(1, 0, At, B0); PG8_BAR; PG8_SCHED;
            PG8_STAGE(PG8_SB(0, 1), b2 + hstep, voffB);
            PG8_WAIT_V(6); PG8_BAR; PG8_MMA(1, 1, At, B1); PG8_BAR;
            PG8_LDB(B0, 1, 0); PG8_SCHED; PG8_LDA(At, 1, 0); PG8_STAGE(PG8_SA(0, 1), a2 + hstep, voffA);
            PG8_WAIT_L(8); PG8_BAR; PG8_WAIT_L(0); PG8_MMA(0, 0, At, B0); PG8_BAR; PG8_SCHED;
            PG8_LDB(B1, 1, 1); PG8_STAGE(PG8_SB(1, 0), b3, voffB);
            PG8_BAR; PG8_WAIT_L(0); PG8_MMA(0, 1, At, B1); PG8_BAR;
            PG8_LDA(At, 1, 1); PG8_STAGE(PG8_SA(1, 0), a3, voffA);
            PG8_BAR; PG8_WAIT_L(0); PG8_MMA(1, 0, At, B0); PG8_BAR; PG8_SCHED;
            PG8_STAGE(PG8_SB(1, 1), b3 + hstep, voffB);
            PG8_WAIT_V(6); PG8_BAR; PG8_MMA(1, 1, At, B1); PG8_BAR;
            }
        }
        if constexpr (ALIGN_EPI) { if (wr == 0) PG8_BAR; }
        if constexpr (!Epi::AFTER_DRAIN) { E(acc, cur, wr, wc, fr, fq); S.done(cur); }
        if (!has_next) break;
#pragma unroll
        for (int a = 0; a < 2; ++a)
#pragma unroll
            for (int b = 0; b < 2; ++b)
#pragma unroll
                for (int m = 0; m < 4; ++m)
#pragma unroll
                    for (int n = 0; n < 2; ++n) acc[a][b][m][n] = (f32x4){0.f, 0.f, 0.f, 0.f};
        cur = nxt; cA = nA; cB = nB; ++ui;
        if constexpr (ALIGN_EPI) { if (wr == 1) PG8_BAR; }
    }
    PG8_WAIT_V(0);
    if constexpr (!ALIGN_EPI) { if (wr == 0) PG8_BAR; }
    PG8_BAR;
    if constexpr (Epi::AFTER_DRAIN) { E.fused(acc, cur, wr, wc, fr, fq, lds, wid, lane); S.done(cur); }
#undef PG8_SA
#undef PG8_SB
#undef PG8_STAGE
#undef PG8_LDA
#undef PG8_LDB
#undef PG8_MMA
#undef PG8_WAIT_V
#undef PG8_WAIT_L
#undef PG8_BAR
#undef PG8_SCHED
}
}
#define GAS __attribute__((address_space(1)))
#define LAS __attribute__((address_space(3)))
typedef unsigned short bf16;
typedef unsigned v4u __attribute__((ext_vector_type(4)));
typedef float f32x4 __attribute__((ext_vector_type(4)));
typedef short bf16x8 __attribute__((ext_vector_type(8)));
typedef GAS unsigned gu32;
typedef GAS unsigned long long gu64;
#define RLX_AGENT __ATOMIC_RELAXED, __HIP_MEMORY_SCOPE_AGENT
#define LDS_WAIT() asm volatile("s_waitcnt lgkmcnt(0)" ::: "memory")
#define VM_WAIT() asm volatile("s_waitcnt vmcnt(0)" ::: "memory")
__device__ __forceinline__ unsigned long long rt() { return __builtin_amdgcn_s_memrealtime(); }
__device__ __forceinline__ unsigned f2bf(float f) { unsigned u = __builtin_bit_cast(unsigned, f); return (u + 0x7fffu + ((u >> 16) & 1u)) >> 16; }
__device__ __forceinline__ unsigned pk2(float lo, float hi) { return f2bf(lo) | (f2bf(hi) << 16); }

#define XB_TMO      128
#define XB_XCNT(j)  (256  + 64 * (j))
#define XB_XSUB(j)  (1280 + 64 * (j))
#define XB_XGEN(j)  (2304 + 64 * (j))
#define XB_TOP      3328
#define XB_TOPGEN   3392
#define XCD_BAR_WORDS 3456
#define XB_SPIN_CAP (1u << 18)

__device__ __forceinline__ unsigned xb_ld(unsigned* p)              { return __hip_atomic_load(p, __ATOMIC_RELAXED, __HIP_MEMORY_SCOPE_AGENT); }
__device__ __forceinline__ unsigned xb_add(unsigned* p, unsigned v) { return __hip_atomic_fetch_add(p, v, __ATOMIC_RELAXED, __HIP_MEMORY_SCOPE_AGENT); }
__device__ __forceinline__ unsigned xb_xcc_id() { return (unsigned)__builtin_amdgcn_s_getreg((3 << 11) | 20) & 0xFu; }
#define XB_SPIN(cond, bar) do { unsigned _sp = 0; while (cond) { __builtin_amdgcn_s_sleep(1); \
    if ((++_sp & 255u) == 0u) { if (xb_ld(&(bar)[XB_TMO])) break; if (_sp > XB_SPIN_CAP) { atomicAdd(&(bar)[XB_TMO], 1u); break; } } } } while (0)

struct XcdBarrier {
    unsigned* bar; unsigned x; int wv;
    volatile LAS unsigned* st;
};

__device__ __forceinline__ XcdBarrier xcd_barrier_post(unsigned* bar, volatile LAS unsigned* st, int wv) {
    XcdBarrier b; b.bar = bar; b.x = xb_xcc_id(); b.st = st; b.wv = wv;
    if (wv == 0 && hw_lane() == 0) (void)xb_add(&bar[XB_XCNT(b.x)], 1u);
    return b;
}
__device__ __forceinline__ void xcd_barrier_complete(unsigned* bar, unsigned x, unsigned& nloc, unsigned& nx) {
    const unsigned G = gridDim.x * gridDim.y * gridDim.z;
    unsigned sum, cnt, mine, sp = 0u;
    for (;;) {
        sum = 0u; cnt = 0u; mine = 0u;
#pragma unroll
        for (unsigned j = 0; j < 16; ++j) { const unsigned c = xb_ld(&bar[XB_XCNT(j)]); sum += c; cnt += (c > 0u) ? 1u : 0u; mine = (j == x) ? c : mine; }
        if (sum == G) break;
        __builtin_amdgcn_s_sleep(1);
        if ((++sp & 255u) == 0u) { if (xb_ld(&bar[XB_TMO])) break; if (sp > XB_SPIN_CAP) { atomicAdd(&bar[XB_TMO], 1u); break; } }
    }
    nloc = mine > 0u ? mine : 1u; nx = cnt > 0u ? cnt : 1u;
}

__device__ __forceinline__ void xcd_barrier(const XcdBarrier& b) {
    asm volatile("s_waitcnt vmcnt(0)" ::: "memory");
    __syncthreads();
    if (b.wv == 0 && hw_lane() == 0) {
        unsigned* bar = b.bar;
        __builtin_amdgcn_s_waitcnt(0);
        unsigned nloc = b.st[0], nx = b.st[1];
        if (nloc == 0u) { xcd_barrier_complete(bar, b.x, nloc, nx); b.st[0] = nloc; b.st[1] = nx; }
        const unsigned old = xb_add(&bar[XB_XSUB(b.x)], 1u);
        const unsigned gen = old / nloc;
        if (old + 1u == (gen + 1u) * nloc) {
            __builtin_amdgcn_fence(__ATOMIC_RELEASE, "agent");
            asm volatile("s_waitcnt vmcnt(0)" ::: "memory");
            const unsigned og = xb_add(&bar[XB_TOP], 1u);
            const unsigned tg = og / nx;
            if (og + 1u == (tg + 1u) * nx) xb_add(&bar[XB_TOPGEN], 1u);
            else XB_SPIN(xb_ld(&bar[XB_TOPGEN]) == tg, bar);
            __builtin_amdgcn_fence(__ATOMIC_ACQUIRE, "agent");
            xb_add(&bar[XB_XGEN(b.x)], 1u);
            asm volatile("s_waitcnt vmcnt(0)" ::: "memory");
        } else {
            XB_SPIN(xb_ld(&bar[XB_XGEN(b.x)]) == gen, bar);
            __builtin_amdgcn_fence(__ATOMIC_ACQUIRE, "agent");
            asm volatile("s_waitcnt vmcnt(0)" ::: "memory");
        }
    }
    __syncthreads();
}
constexpr int NWAVES = 8;
constexpr int T = 32768, D = 1024, SEQ = 4096, NBATCH = 8, NPROJ = 2816, DIN = 2824, FF = 4096, PLE = 256;
constexpr int O_AQ = 0, O_AK = 512, O_AV = 640, O_DQ = 768, O_DK = 1280, O_DV = 1792, O_DZ = 2304;
constexpr float LOG2E = 1.4426950408889634f;
constexpr size_t MiB = 1u << 20;
constexpr size_t WS_CTL = 0, CTL_ZERO_BYTES = 1 * MiB;
constexpr size_t WS_ROPE = 1 * MiB;
constexpr size_t WS_WIN = 2 * MiB, WS_WO = 8 * MiB, WS_WUP = 10 * MiB, WS_WDN = 18 * MiB, WS_WG = 26 * MiB, WS_WP = 28 * MiB;
constexpr size_t WS_R0 = 29 * MiB, WS_SSQ1 = WS_R0 + 131072, WS_SSQ2 = WS_SSQ1 + 131072, WS_SSQ3 = WS_SSQ2 + 131072;
constexpr size_t WS_BLOG = 30 * MiB;
constexpr size_t WS_XB = 32 * MiB;
constexpr size_t WS_PROJ = 96 * MiB;
constexpr size_t WS_PB = 272 * MiB;
constexpr size_t WS_HID = 32 * MiB;
constexpr size_t WS_MIX = 288 * MiB;
constexpr size_t WS_HB = 352 * MiB;
constexpr size_t WS_PP = 416 * MiB;
constexpr size_t WS_REC = 352 * MiB;
constexpr int RECB = 35840;
constexpr int REC_W = 0, REC_QG = 8192, REC_KDT = 16384, REC_A = 24576, REC_U = 26624, REC_HDR = 34816;
constexpr size_t WS_END = 512 * MiB;
static_assert(WS_REC + (size_t)4096 * RECB <= WS_END && WS_PROJ + (size_t)T * NPROJ * 2 <= WS_PB && WS_HID + (size_t)T * FF * 2 <= WS_MIX, "d_ws map");
constexpr int CW_BAR = 4096;
constexpr int RING_BYTES = 131072;
constexpr int LDSCTL_OFF = 155648, MISC_OFF = LDSCTL_OFF + 320;
constexpr int LDS_BYTES = 160 * 1024;

struct Frame {
    LAS unsigned char* lds;
    volatile LAS unsigned* MISC;
    gu32* ctl;
    int tid, lane, wave, vcu, G;
};
__device__ __forceinline__ float wave_sum(float v) {
#pragma unroll
    for (int o = 1; o < 64; o <<= 1) v += __shfl_xor(v, o);
    return v;
}
__device__ __forceinline__ float bf_lo(unsigned w) { return __uint_as_float(w << 16); }
__device__ __forceinline__ float bf_hi(unsigned w) { return __uint_as_float(w & 0xffff0000u); }
__device__ __forceinline__ unsigned cvtpk(float lo, float hi) { return pg8::cvt_pk_bf16(lo, hi); }

template <bool ROPEPERM>
__device__ __forceinline__ void p0_transpose_item(const float* W, int ldw, int K, int nblk, bf16* WT, const float* gain, LAS float* scr, int item, int lane) {
    const int kb = item / nblk, nb = item % nblk, k0 = 64 * kb, n0 = 32 * nb;
#pragma unroll 8
    for (int i = 0; i < 32; ++i) { const int kk = 2 * i + (lane >> 5); float w = W[(size_t)(k0 + kk) * ldw + n0 + (lane & 31)]; if (gain) w *= gain[k0 + kk]; scr[kk * 33 + (lane & 31)] = w; }
    LDS_WAIT(); asm volatile("" ::: "memory");
    const int c = lane & 7;
#pragma unroll
    for (int j = 0; j < 4; ++j) { const int n = (lane >> 3) + 8 * j; const LAS float* s = scr + (8 * c) * 33 + n;
        v4u o; o.x = pk2(s[0 * 33], s[1 * 33]); o.y = pk2(s[2 * 33], s[3 * 33]); o.z = pk2(s[4 * 33], s[5 * 33]); o.w = pk2(s[6 * 33], s[7 * 33]);
        int dn = n0 + n;
        if (ROPEPERM && dn < 640) { const int hd = dn & ~63, r = dn & 63; dn = (r < 32) ? hd + 8 * (r >> 2) + (r & 3) : hd + 8 * ((r - 32) >> 2) + 4 + (r & 3); }
        *(GAS v4u*)(WT + (size_t)dn * K + k0 + 8 * c) = o; }
    LDS_WAIT(); asm volatile("" ::: "memory");
}
struct P0Args { const float *x, *p, *norm_mix, *w_in, *w_o, *norm_mlp, *w_up, *w_down, *norm_ple, *w_gate, *w_proj; unsigned char* ws; };
__device__ __forceinline__ void p0_prologue(Frame& F, const P0Args& A) {
    LAS float* scr = (LAS float*)(F.lds + F.wave * 16384);
    const int gw = F.vcu * NWAVES + F.wave, NGW = F.G * NWAVES;
    bf16* Win_t = (bf16*)(A.ws + WS_WIN); bf16* Wo_t = (bf16*)(A.ws + WS_WO); bf16* Wup_t = (bf16*)(A.ws + WS_WUP); bf16* Wdn_t = (bf16*)(A.ws + WS_WDN); bf16* Wg_t = (bf16*)(A.ws + WS_WG); bf16* Wp_t = (bf16*)(A.ws + WS_WP);
    constexpr int I_IN = (D / 64) * (NPROJ / 32), I_O = (D / 64) * (D / 32), I_UP = (D / 64) * (FF / 32), I_DN = (FF / 64) * (D / 32), I_G = I_O, I_P = (PLE / 64) * (D / 32);
    constexpr int NITEMS = I_IN + I_O + I_UP + I_DN + I_G + I_P;
    for (int it = gw; it < NITEMS; it += NGW) {
        int r = it;
        if (r < I_IN) { p0_transpose_item<true>(A.w_in, DIN, D, NPROJ / 32, Win_t, A.norm_mix, scr, r, F.lane); continue; } r -= I_IN;
        if (r < I_O) { p0_transpose_item<false>(A.w_o, D, D, D / 32, Wo_t, nullptr, scr, r, F.lane); continue; } r -= I_O;
        if (r < I_UP) { p0_transpose_item<false>(A.w_up, FF, D, FF / 32, Wup_t, A.norm_mlp, scr, r, F.lane); continue; } r -= I_UP;
        if (r < I_DN) { p0_transpose_item<false>(A.w_down, D, FF, D / 32, Wdn_t, nullptr, scr, r, F.lane); continue; } r -= I_DN;
        if (r < I_G) { p0_transpose_item<false>(A.w_gate, D, D, D / 32, Wg_t, A.norm_ple, scr, r, F.lane); continue; } r -= I_G;
        p0_transpose_item<false>(A.w_proj, D, PLE, D / 32, Wp_t, nullptr, scr, r, F.lane);
    }
    __syncthreads();
    LAS float* wg8 = (LAS float*)F.lds;
    for (int i = F.tid; i < 1024 * 8; i += NWAVES * 64) { const int k = i >> 3, c = i & 7; wg8[i] = A.w_in[(size_t)k * DIN + NPROJ + c] * A.norm_mix[k]; }
    __syncthreads();
    bf16* XB = (bf16*)(A.ws + WS_XB); float* R0 = (float*)(A.ws + WS_R0); float* BLOG = (float*)(A.ws + WS_BLOG);
    for (int m = gw; m < T; m += NGW) {
        const GAS f32x4* xr = (const GAS f32x4*)(A.x + (size_t)m * D) + F.lane;
        f32x4 v[4]; float s = 0.f; float lg[8];
#pragma unroll
        for (int c = 0; c < 8; ++c) lg[c] = 0.f;
#pragma unroll
        for (int j = 0; j < 4; ++j) { v[j] = xr[64 * j]; s += (v[j].x * v[j].x + v[j].y * v[j].y) + (v[j].z * v[j].z + v[j].w * v[j].w); }
#pragma unroll
        for (int j = 0; j < 4; ++j)
#pragma unroll
            for (int e = 0; e < 4; ++e) { const int k = 256 * j + 4 * F.lane + e; const LAS f32x4* wp = (const LAS f32x4*)(wg8 + k * 8); const f32x4 wa = wp[0], wb = wp[1]; const float xv = v[j][e];
                lg[0] += xv * wa.x; lg[1] += xv * wa.y; lg[2] += xv * wa.z; lg[3] += xv * wa.w; lg[4] += xv * wb.x; lg[5] += xv * wb.y; lg[6] += xv * wb.z; lg[7] += xv * wb.w; }
        const float r0 = 1.0f / sqrtf(wave_sum(s) * (1.f / D) + pg8::RMS_EPS);
#pragma unroll
        for (int c = 0; c < 8; ++c) lg[c] = wave_sum(lg[c]);
        GAS unsigned long long* o8 = (GAS unsigned long long*)(XB + (size_t)m * D) + F.lane;
#pragma unroll
        for (int j = 0; j < 4; ++j) o8[64 * j] = (unsigned long long)pk2(v[j].x, v[j].y) | ((unsigned long long)pk2(v[j].z, v[j].w) << 32);
        if (F.lane == 0) R0[m] = r0;
        if (F.lane < 8) { float val = lg[0];
#pragma unroll
            for (int c = 1; c < 8; ++c) val = (F.lane == c) ? lg[c] : val;
            BLOG[(size_t)m * 8 + F.lane] = val * r0; }
    }
    { const size_t n8 = (size_t)T * PLE / 8; bf16* PB = (bf16*)(A.ws + WS_PB);
      for (size_t i = (size_t)blockIdx.x * (NWAVES * 64) + F.tid; i < n8; i += (size_t)F.G * NWAVES * 64) { const f32x4 a = ((const GAS f32x4*)A.p)[2 * i], b = ((const GAS f32x4*)A.p)[2 * i + 1];
          v4u o; o.x = pk2(a.x, a.y); o.y = pk2(a.z, a.w); o.z = pk2(b.x, b.y); o.w = pk2(b.z, b.w); ((GAS v4u*)PB)[i] = o; } }
    { float* cs = (float*)(A.ws + WS_ROPE); float* sn = cs + SEQ * 32;
      for (int i = blockIdx.x * (NWAVES * 64) + F.tid; i < SEQ * 32; i += F.G * NWAVES * 64) { const int pos = i >> 5, j = i & 31;
          const float inv = 1.0f / powf(10000.0f, (float)j * (2.0f / 64.0f)); const float ang = (float)pos * inv; cs[i] = cosf(ang); sn[i] = sinf(ang); } }
    { float* z = (float*)(A.ws + WS_SSQ1); for (int i = blockIdx.x * (NWAVES * 64) + F.tid; i < 3 * T; i += F.G * NWAVES * 64) z[i] = 0.f; }
}
typedef short bf16x8 __attribute__((ext_vector_type(8)));
typedef float f32x16 __attribute__((ext_vector_type(16)));
typedef unsigned u32x2 __attribute__((ext_vector_type(2)));
__device__ __forceinline__ int crow32(int i, int hh) { return (i & 3) + 8 * (i >> 2) + 4 * hh; }
constexpr int P2_QN = 0, P2_KN = 16384, P2_R = 32768, P2_L = 98304, P2_AT = 107520, P2_GS = 111616, P2_CW = 112384;
__device__ __forceinline__ void dnprep_unit(Frame& F, const bf16* proj, const float* blog, const float* conv_w, const float* a_log, const float* dt_bias, unsigned char* rec_base, int b, int h, int blk) {
    LAS unsigned char* L = F.lds;
    const int tid = F.tid, lane = F.lane, wave = F.wave;
    int c = tid >> 3, seg = tid & 7; asm volatile("" : "+v"(c), "+v"(seg));
    LAS float* GS = (LAS float*)(L + P2_GS);
    LAS float* CW = (LAS float*)(L + P2_CW);
    LAS float* R = (LAS float*)(L + P2_R);
    LAS float* Lm = (LAS float*)(L + P2_L);
    LAS bf16* AT = (LAS bf16*)(L + P2_AT);
    for (int i = tid; i < 1536; i += NWAVES * 64) { const int w = i >> 9, j = (i >> 7) & 3, d = i & 127; CW[i] = conv_w[j * 1536 + w * 512 + h * 128 + d]; }
    const int t = blk * 64 + c; const size_t grow = (size_t)b * SEQ + t;
    const float bl = blog[grow * 8 + h], al = blog[grow * 8 + 4 + h] + dt_bias[h];
    const float beta = 1.f / (1.f + expf(-bl));
    const float sp = al > 20.f ? al : log1pf(expf(al));
    const float g = -expf(a_log[h]) * sp;
    if (seg == 0) { GS[c] = g; GS[128 + c] = beta; }
    __syncthreads();
    if (wave == 0) { float v = GS[lane];
#pragma unroll
        for (int o = 1; o < 32; o <<= 1) { const float tt = __shfl_up(v, o, 32); if ((lane & 31) >= o) v += tt; }
        GS[64 + lane] = v; }
    float xq[16], xk[16], xv[16];
#pragma unroll
    for (int e = 0; e < 16; ++e) { xq[e] = 0.f; xk[e] = 0.f; xv[e] = 0.f; }
#pragma unroll
    for (int j = 0; j < 4; ++j) {
        const int tt = t - 3 + j;
        if (tt >= 0) {
            const bf16* rp = proj + ((size_t)b * SEQ + tt) * NPROJ + h * 128 + 16 * seg;
            const v4u q0 = *(const GAS v4u*)(rp + O_DQ), q1 = *(const GAS v4u*)(rp + O_DQ + 8), k0 = *(const GAS v4u*)(rp + O_DK), k1 = *(const GAS v4u*)(rp + O_DK + 8), v0 = *(const GAS v4u*)(rp + O_DV), v1 = *(const GAS v4u*)(rp + O_DV + 8);
            const unsigned qw[8] = {q0.x, q0.y, q0.z, q0.w, q1.x, q1.y, q1.z, q1.w}, kw[8] = {k0.x, k0.y, k0.z, k0.w, k1.x, k1.y, k1.z, k1.w}, vw[8] = {v0.x, v0.y, v0.z, v0.w, v1.x, v1.y, v1.z, v1.w};
            const LAS float* cq = CW + (0 * 4 + j) * 128 + 16 * seg; const LAS float* ck = CW + (1 * 4 + j) * 128 + 16 * seg; const LAS float* cv = CW + (2 * 4 + j) * 128 + 16 * seg;
#pragma unroll
            for (int e = 0; e < 8; ++e) {
                xq[2 * e] = fmaf(cq[2 * e], bf_lo(qw[e]), xq[2 * e]); xq[2 * e + 1] = fmaf(cq[2 * e + 1], bf_hi(qw[e]), xq[2 * e + 1]);
                xk[2 * e] = fmaf(ck[2 * e], bf_lo(kw[e]), xk[2 * e]); xk[2 * e + 1] = fmaf(ck[2 * e + 1], bf_hi(kw[e]), xk[2 * e + 1]);
                xv[2 * e] = fmaf(cv[2 * e], bf_lo(vw[e]), xv[2 * e]); xv[2 * e + 1] = fmaf(cv[2 * e + 1], bf_hi(vw[e]), xv[2 * e + 1]);
            }
        }
    }
    float sq = 0.f, sk = 0.f;
#pragma unroll
    for (int e = 0; e < 16; ++e) { xq[e] = xq[e] / (1.f + __expf(-xq[e])); xk[e] = xk[e] / (1.f + __expf(-xk[e])); xv[e] = xv[e] / (1.f + __expf(-xv[e])); sq += xq[e] * xq[e]; sk += xk[e] * xk[e]; }
    sq += __shfl_xor(sq, 1); sq += __shfl_xor(sq, 2); sq += __shfl_xor(sq, 4);
    sk += __shfl_xor(sk, 1); sk += __shfl_xor(sk, 2); sk += __shfl_xor(sk, 4);
    const float rq = 0.08838834764831845f / sqrtf(sq + 1e-6f), rk = 1.0f / sqrtf(sk + 1e-6f);
    __syncthreads();
    const float gc = GS[64 + c], glast = GS[64 + (c & 32) + 31];
    const float eg = expf(gc), ekd = expf(glast - gc);
#pragma unroll
    for (int e = 0; e < 16; ++e) { xq[e] *= rq; xk[e] *= rk; }
#pragma unroll
    for (int i = 0; i < 2; ++i) {
        v4u wq, wk;
        wq.x = cvtpk(xq[8 * i + 0], xq[8 * i + 1]); wq.y = cvtpk(xq[8 * i + 2], xq[8 * i + 3]); wq.z = cvtpk(xq[8 * i + 4], xq[8 * i + 5]); wq.w = cvtpk(xq[8 * i + 6], xq[8 * i + 7]);
        wk.x = cvtpk(xk[8 * i + 0], xk[8 * i + 1]); wk.y = cvtpk(xk[8 * i + 2], xk[8 * i + 3]); wk.z = cvtpk(xk[8 * i + 4], xk[8 * i + 5]); wk.w = cvtpk(xk[8 * i + 6], xk[8 * i + 7]);
        const int off = c * 256 + (((2 * seg + i) ^ (c & 7)) << 4);
        *(LAS v4u*)(L + P2_QN + off) = wq; *(LAS v4u*)(L + P2_KN + off) = wk;
    }
#pragma unroll
    for (int e4 = 0; e4 < 4; ++e4) {
        f32x4 rv, rw;
#pragma unroll
        for (int e = 0; e < 4; ++e) { rv[e] = xv[4 * e4 + e] * beta; rw[e] = xk[4 * e4 + e] * (beta * eg); }
        *(LAS f32x4*)(R + c * 256 + 16 * seg + 4 * e4) = rv; *(LAS f32x4*)(R + c * 256 + 128 + 16 * seg + 4 * e4) = rw;
    }
    __syncthreads();
    if (wave < 4) {
        const int ch = wave & 1, which = wave >> 1; int r = lane & 31, hh = lane >> 5; asm volatile("" : "+v"(r), "+v"(hh));
        f32x16 acc;
#pragma unroll
        for (int i = 0; i < 16; ++i) acc[i] = 0.f;
        const int rowoff = (32 * ch + r) * 256;
#pragma unroll
        for (int ks = 0; ks < 8; ++ks) {
            const int off = rowoff + (((2 * ks + hh) ^ (r & 7)) << 4);
            const bf16x8 bb = *(const LAS bf16x8*)(L + P2_KN + off);
            const bf16x8 aa = *(const LAS bf16x8*)(L + (which ? P2_QN : P2_KN) + off);
            acc = __builtin_amdgcn_mfma_f32_32x32x16_bf16(aa, bb, acc, 0, 0, 0);
        }
        const float gs_ = GS[64 + 32 * ch + r];
#pragma unroll
        for (int i = 0; i < 16; ++i) {
            const int cp = crow32(i, hh); const float gcc = GS[64 + 32 * ch + cp];
            const float dec = expf(fminf(gcc - gs_, 0.f));
            if (which == 0) { const float val = (r < cp) ? GS[128 + 32 * ch + cp] * acc[i] * dec : 0.f; Lm[(ch * 32 + cp) * 36 + r] = val; }
            else { const float val = (r <= cp) ? acc[i] * dec : 0.f; AT[(ch * 32 + cp) * 32 + r] = (bf16)(cvtpk(val, 0.f) & 0xffffu); }
        }
    }
    __syncthreads();
    {
        const int ch = tid >> 8, j = tid & 255;
        LAS float* Rc = R + (32 * ch) * 256 + j; const LAS float* Lc = Lm + ch * 32 * 36;
        float x[32];
#pragma unroll
        for (int c2 = 0; c2 < 32; ++c2) {
            float a = Rc[c2 * 256];
#pragma unroll
            for (int v = 0; v < (c2 + 3) / 4; ++v) { const f32x4 l4 = *(const LAS f32x4*)(Lc + c2 * 36 + 4 * v);
#pragma unroll
                for (int e = 0; e < 4; ++e) if (4 * v + e < c2) a = fmaf(-l4[e], x[4 * v + e], a); }
            x[c2] = a; Rc[c2 * 256] = a;
        }
    }
#pragma unroll
    for (int i = 0; i < 2; ++i) {
        v4u wq, wk;
        wq.x = cvtpk(xq[8 * i + 0] * eg, xq[8 * i + 1] * eg); wq.y = cvtpk(xq[8 * i + 2] * eg, xq[8 * i + 3] * eg); wq.z = cvtpk(xq[8 * i + 4] * eg, xq[8 * i + 5] * eg); wq.w = cvtpk(xq[8 * i + 6] * eg, xq[8 * i + 7] * eg);
        wk.x = cvtpk(xk[8 * i + 0] * ekd, xk[8 * i + 1] * ekd); wk.y = cvtpk(xk[8 * i + 2] * ekd, xk[8 * i + 3] * ekd); wk.z = cvtpk(xk[8 * i + 4] * ekd, xk[8 * i + 5] * ekd); wk.w = cvtpk(xk[8 * i + 6] * ekd, xk[8 * i + 7] * ekd);
        *(LAS v4u*)(L + P2_QN + c * 256 + 32 * seg + 16 * i) = wq; *(LAS v4u*)(L + P2_KN + c * 256 + 32 * seg + 16 * i) = wk;
    }
    __syncthreads();
    unsigned char* rec0 = rec_base + (size_t)((b * 4 + h) * 128 + blk * 2) * RECB;
    const LAS bf16* QG = (const LAS bf16*)(L + P2_QN); const LAS bf16* KD = (const LAS bf16*)(L + P2_KN);
    for (int p = tid; p < 2 * 26 * 64; p += NWAVES * 64) {
        const int ch = p / 1664, rem = p - ch * 1664, f = rem >> 6, l = rem & 63, r = l & 15, q = l >> 4;
        v4u o;
        if (f < 8) { const int mt = f >> 2, ks = f & 3; const LAS float* rp = R + (32 * ch + 16 * mt + r) * 256 + 128 + 32 * ks + 4 * q;
            const f32x4 a = *(const LAS f32x4*)rp, bq = *(const LAS f32x4*)(rp + 16);
            o.x = cvtpk(a[0], a[1]); o.y = cvtpk(a[2], a[3]); o.z = cvtpk(bq[0], bq[1]); o.w = cvtpk(bq[2], bq[3]); }
        else if (f < 16) { const int mt = (f - 8) >> 2, ks = (f - 8) & 3; const LAS bf16* rp = QG + (32 * ch + 16 * mt + r) * 128 + 32 * ks + 4 * q;
            const u32x2 a = *(const LAS u32x2*)rp, bq = *(const LAS u32x2*)(rp + 16); o.x = a.x; o.y = a.y; o.z = bq.x; o.w = bq.y; }
        else if (f < 24) { const int mt = f - 16; const LAS bf16* cp = KD + (32 * ch + 4 * q) * 128 + 16 * mt + r;
            const unsigned e0 = cp[0], e1 = cp[128], e2 = cp[256], e3 = cp[384], e4 = cp[16 * 128], e5 = cp[17 * 128], e6 = cp[18 * 128], e7 = cp[19 * 128];
            o.x = e0 | (e1 << 16); o.y = e2 | (e3 << 16); o.z = e4 | (e5 << 16); o.w = e6 | (e7 << 16); }
        else { const int mt = f - 24; const LAS bf16* rp = AT + (ch * 32 + 16 * mt + r) * 32 + 4 * q;
            const u32x2 a = *(const LAS u32x2*)rp, bq = *(const LAS u32x2*)(rp + 16); o.x = a.x; o.y = a.y; o.z = bq.x; o.w = bq.y; }
        *(GAS v4u*)(rec0 + (size_t)ch * RECB + f * 1024 + l * 16) = o;
    }
    for (int p = tid; p < 1024; p += NWAVES * 64) {
        const int ch = p >> 9, pi = p & 511, slice = pi >> 6, w = pi & 63, mt = w >> 5, lp = w & 31;
        v4u o; unsigned ww[4];
#pragma unroll
        for (int k = 0; k < 2; ++k) { const int l = 2 * lp + k, r = l & 15, q = l >> 4; const LAS float* rp = R + (32 * ch + 16 * mt + 4 * q) * 256 + 16 * slice + r;
            ww[2 * k] = cvtpk(rp[0], rp[256]); ww[2 * k + 1] = cvtpk(rp[512], rp[768]); }
        o.x = ww[0]; o.y = ww[1]; o.z = ww[2]; o.w = ww[3];
        *(GAS v4u*)(rec0 + (size_t)ch * RECB + REC_U + slice * 1024 + mt * 512 + lp * 16) = o;
    }
    if ((tid & 255) == 0) { const int ch = tid >> 8; *(float*)(rec0 + (size_t)ch * RECB + REC_HDR) = expf(GS[64 + 32 * ch + 31]); }
    __syncthreads();
}

constexpr int SC_SLOT = 28672;
#define SC_WAIT(n) asm volatile("s_waitcnt vmcnt(" #n ")" ::: "memory")
__device__ __forceinline__ void scan_task(Frame& F, const unsigned char* rec_base, float* odn) {
    const int lane = F.lane, r = lane & 15, q = lane >> 4;
    const int bx = blockIdx.x, xcd = bx & 7, idx = bx >> 3, bh = xcd * 4 + (idx >> 3), slice = idx & 7, b = bh >> 2, h = bh & 3;
    const unsigned char* rb = rec_base + (size_t)bh * 128 * RECB + lane * 16;
    LAS unsigned char* ring = F.lds;
#define SC_ISSUE(ci, slot_) do { const unsigned char* g_ = rb + (size_t)(ci) * RECB; LAS unsigned char* l_ = ring + (slot_) * SC_SLOT; \
        _Pragma("unroll") for (int p_ = 0; p_ < 26; ++p_) __builtin_amdgcn_global_load_lds((const unsigned*)(g_ + p_ * 1024), (LAS unsigned*)(l_ + p_ * 1024), 16, 0, 0); \
        __builtin_amdgcn_global_load_lds((const unsigned*)(g_ + REC_U + slice * 1024), (LAS unsigned*)(l_ + 26624), 16, 0, 0); \
        __builtin_amdgcn_global_load_lds((const unsigned*)(g_ + REC_HDR), (LAS unsigned*)(l_ + 27648), 16, 0, 0); } while (0)
    f32x4 S[8];
#pragma unroll
    for (int i = 0; i < 8; ++i) S[i] = (f32x4){0.f, 0.f, 0.f, 0.f};
    SC_ISSUE(0, 0); SC_ISSUE(1, 1);
    int slot = 0;
    float* obase = odn + ((size_t)b * SEQ + 4 * q) * 512 + h * 128 + 16 * slice + r;
    for (int i = 0; i < 128; ++i) {
        if (i == 0) SC_WAIT(28); else if (i == 1) SC_WAIT(36); else SC_WAIT(44);
        { const int nx = (i + 2 < 128) ? i + 2 : 127; int ns = slot + 2; if (ns >= 3) ns -= 3; SC_ISSUE(nx, ns); }
        const LAS unsigned char* sp = ring + slot * SC_SLOT + lane * 16;
        const float dl = *(const LAS float*)(ring + slot * SC_SLOT + 27648);
        bf16x8 Sb[4];
#pragma unroll
        for (int ks = 0; ks < 4; ++ks) { v4u w; w.x = cvtpk(S[2 * ks][0], S[2 * ks][1]); w.y = cvtpk(S[2 * ks][2], S[2 * ks][3]); w.z = cvtpk(S[2 * ks + 1][0], S[2 * ks + 1][1]); w.w = cvtpk(S[2 * ks + 1][2], S[2 * ks + 1][3]); Sb[ks] = __builtin_bit_cast(bf16x8, w); }
        f32x4 P[2], O[2];
#pragma unroll
        for (int mt = 0; mt < 2; ++mt) { P[mt] = (f32x4){0.f, 0.f, 0.f, 0.f}; O[mt] = (f32x4){0.f, 0.f, 0.f, 0.f}; }
#pragma unroll
        for (int mt = 0; mt < 2; ++mt)
#pragma unroll
            for (int ks = 0; ks < 4; ++ks) {
                P[mt] = __builtin_amdgcn_mfma_f32_16x16x32_bf16(*(const LAS bf16x8*)(sp + REC_W + (mt * 4 + ks) * 1024), Sb[ks], P[mt], 0, 0, 0);
                O[mt] = __builtin_amdgcn_mfma_f32_16x16x32_bf16(*(const LAS bf16x8*)(sp + REC_QG + (mt * 4 + ks) * 1024), Sb[ks], O[mt], 0, 0, 0);
            }
        f32x4 vn[2];
#pragma unroll
        for (int mt = 0; mt < 2; ++mt) { const u32x2 uw = *(const LAS u32x2*)(ring + slot * SC_SLOT + 26624 + mt * 512 + lane * 8);
            vn[mt][0] = bf_lo(uw.x) - P[mt][0]; vn[mt][1] = bf_hi(uw.x) - P[mt][1]; vn[mt][2] = bf_lo(uw.y) - P[mt][2]; vn[mt][3] = bf_hi(uw.y) - P[mt][3]; }
        bf16x8 Vb; { v4u w; w.x = cvtpk(vn[0][0], vn[0][1]); w.y = cvtpk(vn[0][2], vn[0][3]); w.z = cvtpk(vn[1][0], vn[1][1]); w.w = cvtpk(vn[1][2], vn[1][3]); Vb = __builtin_bit_cast(bf16x8, w); }
#pragma unroll
        for (int m8 = 0; m8 < 8; ++m8) S[m8] = __builtin_amdgcn_mfma_f32_16x16x32_bf16(*(const LAS bf16x8*)(sp + REC_KDT + m8 * 1024), Vb, S[m8] * dl, 0, 0, 0);
#pragma unroll
        for (int mt = 0; mt < 2; ++mt) O[mt] = __builtin_amdgcn_mfma_f32_16x16x32_bf16(*(const LAS bf16x8*)(sp + REC_A + mt * 1024), Vb, O[mt], 0, 0, 0);
        float* op = obase + (size_t)(32 * i) * 512;
#pragma unroll
        for (int mt = 0; mt < 2; ++mt)
#pragma unroll
            for (int reg = 0; reg < 4; ++reg) op[(size_t)(16 * mt + reg) * 512] = O[mt][reg];
        slot = (slot == 2) ? 0 : slot + 1;
    }
    SC_WAIT(0);
#undef SC_ISSUE
}

__device__ __forceinline__ void attn_wave_unit(const bf16* proj, bf16* mix, const float* sinks, int b, int hq, int qt, LAS unsigned short* vt, int lane) {
    int r = lane & 31, hh = lane >> 5; asm volatile("" : "+v"(r), "+v"(hh)); const int kvh = hq >> 2, q0 = qt * 32, kbase = q0 - 128;
    const size_t rowb = (size_t)b * SEQ;
    const int kt0 = (kbase < 0) ? ((-kbase) >> 5) : 0;
    bf16x8 qf[4];
    { const bf16* qp = proj + (rowb + q0 + r) * NPROJ + O_AQ + hq * 64 + 8 * hh;
#pragma unroll
      for (int ds = 0; ds < 4; ++ds) qf[ds] = *(const GAS bf16x8*)(qp + 16 * ds); }
    f32x16 st[5];
#pragma unroll
    for (int kt = 0; kt < 5; ++kt) {
#pragma unroll
        for (int i = 0; i < 16; ++i) st[kt][i] = 0.f;
        if (kt >= kt0) {
            const bf16* kp = proj + (rowb + kbase + 32 * kt + r) * NPROJ + O_AK + kvh * 64 + 8 * hh;
#pragma unroll
            for (int ds = 0; ds < 4; ++ds) { const bf16x8 kf = *(const GAS bf16x8*)(kp + 16 * ds); st[kt] = __builtin_amdgcn_mfma_f32_32x32x16_bf16(kf, qf[ds], st[kt], 0, 0, 0); }
        }
    }
    const float sk2 = sinks[hq] * LOG2E;
    float m = sk2;
#pragma unroll
    for (int kt = 0; kt < 5; ++kt)
#pragma unroll
        for (int i = 0; i < 16; ++i) { const int kk = crow32(i, hh);
            bool valid = (kt >= kt0); if (kt == 0) valid = valid && (kk > r); if (kt == 4) valid = valid && (kk <= r);
            const float s = valid ? st[kt][i] : -INFINITY; st[kt][i] = s; m = fmaxf(m, s); }
    m = fmaxf(m, __shfl_xor(m, 32));
    float l = 0.f;
#pragma unroll
    for (int kt = 0; kt < 5; ++kt)
#pragma unroll
        for (int i = 0; i < 16; ++i) { const float p = __builtin_amdgcn_exp2f(st[kt][i] - m); st[kt][i] = p; l += p; }
    l += __shfl_xor(l, 32); l += __builtin_amdgcn_exp2f(sk2 - m);
    f32x16 o[2];
#pragma unroll
    for (int i = 0; i < 16; ++i) { o[0][i] = 0.f; o[1][i] = 0.f; }
#pragma unroll
    for (int kt = 0; kt < 5; ++kt) {
        if (kt >= kt0) {
            const bf16* vp = proj + (rowb + kbase + 32 * kt + (lane >> 1)) * NPROJ + O_AV + kvh * 64 + 32 * (lane & 1);
            v4u vv[4];
#pragma unroll
            for (int cc = 0; cc < 4; ++cc) vv[cc] = *(const GAS v4u*)(vp + 8 * cc);
            LAS unsigned short* vw = vt + (32 * (lane & 1)) * 36 + (lane >> 1);
#pragma unroll
            for (int cc = 0; cc < 4; ++cc) { const unsigned w4[4] = {vv[cc].x, vv[cc].y, vv[cc].z, vv[cc].w};
#pragma unroll
                for (int e = 0; e < 4; ++e) { vw[(8 * cc + 2 * e) * 36] = (unsigned short)(w4[e] & 0xffffu); vw[(8 * cc + 2 * e + 1) * 36] = (unsigned short)(w4[e] >> 16); } }
#pragma unroll
            for (int s = 0; s < 2; ++s) {
                v4u pw; pw.x = cvtpk(st[kt][8 * s + 0], st[kt][8 * s + 1]); pw.y = cvtpk(st[kt][8 * s + 2], st[kt][8 * s + 3]); pw.z = cvtpk(st[kt][8 * s + 4], st[kt][8 * s + 5]); pw.w = cvtpk(st[kt][8 * s + 6], st[kt][8 * s + 7]);
                const bf16x8 pb = __builtin_bit_cast(bf16x8, pw);
#pragma unroll
                for (int dt = 0; dt < 2; ++dt) {
                    const LAS unsigned short* ap = vt + (32 * dt + r) * 36 + 16 * s + 4 * hh;
                    const u32x2 a0 = *(const LAS u32x2*)ap, a1 = *(const LAS u32x2*)(ap + 8);
                    v4u aw; aw.x = a0.x; aw.y = a0.y; aw.z = a1.x; aw.w = a1.y;
                    o[dt] = __builtin_amdgcn_mfma_f32_32x32x16_bf16(__builtin_bit_cast(bf16x8, aw), pb, o[dt], 0, 0, 0);
                }
            }
        }
    }
    const float il = 1.0f / l;
    bf16* op = mix + (rowb + q0 + r) * D + hq * 64 + 4 * hh;
#pragma unroll
    for (int dt = 0; dt < 2; ++dt)
#pragma unroll
        for (int i4 = 0; i4 < 4; ++i4) { u32x2 w; w.x = cvtpk(o[dt][4 * i4] * il, o[dt][4 * i4 + 1] * il); w.y = cvtpk(o[dt][4 * i4 + 2] * il, o[dt][4 * i4 + 3] * il);
            *(GAS u32x2*)(op + 32 * dt + 8 * i4) = w; }
}

__device__ __forceinline__ void dnnorm_rows(Frame& F, const float* odn, const bf16* proj, const float* dn_norm, bf16* mix) {
    const int gw = F.vcu * NWAVES + F.wave, NGW = F.G * NWAVES, lane = F.lane;
    const int d0 = (lane & 15) * 8;
    const f32x4 n0 = *(const GAS f32x4*)(dn_norm + d0), n1 = *(const GAS f32x4*)(dn_norm + d0 + 4);
    for (int m = gw; m < T; m += NGW) {
        const f32x4 a = *(const GAS f32x4*)(odn + (size_t)m * 512 + lane * 8), bq = *(const GAS f32x4*)(odn + (size_t)m * 512 + lane * 8 + 4);
        const v4u z = *(const GAS v4u*)(proj + (size_t)m * NPROJ + O_DZ + lane * 8);
        float s = (a[0] * a[0] + a[1] * a[1]) + (a[2] * a[2] + a[3] * a[3]) + (bq[0] * bq[0] + bq[1] * bq[1]) + (bq[2] * bq[2] + bq[3] * bq[3]);
        s += __shfl_xor(s, 1); s += __shfl_xor(s, 2); s += __shfl_xor(s, 4); s += __shfl_xor(s, 8);
        const float rn = 1.0f / sqrtf(s * (1.f / 128.f) + 1e-6f);
        const float zz[8] = {bf_lo(z.x), bf_hi(z.x), bf_lo(z.y), bf_hi(z.y), bf_lo(z.z), bf_hi(z.z), bf_lo(z.w), bf_hi(z.w)};
        const float ov[8] = {a[0] * n0[0], a[1] * n0[1], a[2] * n0[2], a[3] * n0[3], bq[0] * n1[0], bq[1] * n1[1], bq[2] * n1[2], bq[3] * n1[3]};
        float y[8];
#pragma unroll
        for (int e = 0; e < 8; ++e) y[e] = ov[e] * rn * (zz[e] / (1.f + __expf(-zz[e])));
        v4u o; o.x = cvtpk(y[0], y[1]); o.y = cvtpk(y[2], y[3]); o.z = cvtpk(y[4], y[5]); o.w = cvtpk(y[6], y[7]);
        *(GAS v4u*)(mix + (size_t)m * D + 512 + lane * 8) = o;
    }
}
__device__ __forceinline__ void final_rows(Frame& F, float* out, const float* ssq3, const float* gfin) {
    const int gw = F.vcu * NWAVES + F.wave, NGW = F.G * NWAVES, lane = F.lane;
    f32x4 gg[4];
#pragma unroll
    for (int j = 0; j < 4; ++j) gg[j] = *(const GAS f32x4*)(gfin + 4 * lane + 256 * j);
    for (int m = gw; m < T; m += NGW) {
        const float rs = 1.0f / sqrtf(ssq3[m] * (1.f / 1024.f) + 1e-6f);
        GAS f32x4* o = (GAS f32x4*)(out + (size_t)m * D) + lane;
#pragma unroll
        for (int j = 0; j < 4; ++j) { f32x4 v = o[64 * j]; v = v * rs * gg[j]; o[64 * j] = v; }
    }
}
#ifndef MK_N_LAUNCHES
#define MK_N_LAUNCHES 1
#endif
constexpr int N_PHASES = 10;
struct Args { const float* in[17]; float* out; unsigned char* ws; int ph_lo, ph_hi, li, pad; };
typedef const __attribute__((address_space(4))) Args* KArgs;
__device__ __forceinline__ KArgs kargs_() { auto p = __builtin_amdgcn_kernarg_segment_ptr(); asm volatile("" : "+s"(p)); return (KArgs)p; }
__global__ void __launch_bounds__(NWAVES * 64, 2) mk_fwd(Args args_unused) {
    extern __shared__ __attribute__((aligned(16))) unsigned char lds[];
    Frame F;
    F.lds = (LAS unsigned char*)lds;
    F.MISC = (volatile LAS unsigned*)(F.lds + MISC_OFF);
    F.tid = threadIdx.x; F.lane = F.tid & 63; F.wave = __builtin_amdgcn_readfirstlane(F.tid >> 6);
    F.G = gridDim.x; { const int bx = blockIdx.x; F.vcu = (F.G % 8 == 0) ? (bx % 8) * (F.G / 8) + bx / 8 : bx; }
    for (int u = F.tid; u < (LDS_BYTES - LDSCTL_OFF) / 4; u += NWAVES * 64) ((LAS unsigned*)(F.lds + LDSCTL_OFF))[u] = 0u;
    __syncthreads();
    XcdBarrier bar;
    { KArgs ka = kargs_(); F.ctl = (gu32*)(ka->ws + WS_CTL); bar.bar = (unsigned*)(F.ctl + CW_BAR) + ka->li * XCD_BAR_WORDS; bar.x = 0; bar.st = nullptr; bar.wv = F.wave;
      if (ka->ph_hi - ka->ph_lo > 1) bar = xcd_barrier_post(bar.bar, F.MISC + 8, F.wave); }
#define IN(k) (ka->ph_lo <= (k) && (k) < ka->ph_hi)
#define SEAM(k) do { KArgs ka = kargs_(); F.lane = hw_lane(); F.tid = F.wave * 64 + F.lane; if (IN(k) && IN((k) + 1)) xcd_barrier(bar); } while (0)
#define WSP(T_, off) ((T_*)(ka->ws + (off)))
    { KArgs ka = kargs_(); F.lane = hw_lane(); F.tid = F.wave * 64 + F.lane; if (IN(0)) {
        P0Args A{ka->in[0], ka->in[1], ka->in[2], ka->in[3], ka->in[9], ka->in[10], ka->in[11], ka->in[12], ka->in[13], ka->in[14], ka->in[15], ka->ws};
        p0_prologue(F, A); } }
    SEAM(0);
    { KArgs ka = kargs_(); F.lane = hw_lane(); F.tid = F.wave * 64 + F.lane; if (IN(1)) {
        pg8::Gemm g{WSP(bf16, WS_XB), WSP(const bf16, WS_WIN), T, NPROJ, D}; pg8::StaticOrder S; S.init(T, NPROJ, F.G, (int)blockIdx.x);
        pg8::EpiProj E{WSP(bf16, WS_PROJ), WSP(const float, WS_R0), WSP(const float, WS_ROPE), WSP(const float, WS_ROPE) + SEQ * 32};
        pg8::gemm_phase<pg8::EpiProj, pg8::StaticOrder, true, true>(F.lds, g, S, E, F.wave); } }
    SEAM(1);
    { KArgs ka = kargs_(); F.lane = hw_lane(); F.tid = F.wave * 64 + F.lane; if (IN(2)) {
        for (int n = F.vcu; n < 2048; n += F.G) dnprep_unit(F, WSP(const bf16, WS_PROJ), WSP(const float, WS_BLOG), ka->in[4], ka->in[5], ka->in[6], ka->ws + WS_REC, n >> 8, (n >> 6) & 3, n & 63); } }
    SEAM(2);
    { KArgs ka = kargs_(); F.lane = hw_lane(); F.tid = F.wave * 64 + F.lane; if (IN(3)) {
        if (F.wave == 0) { if (F.G == 256) scan_task(F, ka->ws + WS_REC, ka->out); }
        else {
            LAS unsigned short* vt = (LAS unsigned short*)(F.lds + 3 * SC_SLOT + (F.wave - 1) * 4608);
            for (int u = F.vcu * 7 + (F.wave - 1); u < 8192; u += F.G * 7) { const int g4 = u & 3, qt = (u >> 2) & 127, bk = u >> 9;
                attn_wave_unit(WSP(const bf16, WS_PROJ), WSP(bf16, WS_MIX), ka->in[8], bk >> 1, (bk & 1) * 4 + g4, qt, vt, F.lane); }
        } } }
    SEAM(3);
    { KArgs ka = kargs_(); F.lane = hw_lane(); F.tid = F.wave * 64 + F.lane; if (IN(4)) {
        dnnorm_rows(F, ka->out, WSP(const bf16, WS_PROJ), ka->in[7], WSP(bf16, WS_MIX));
        pg8::Gemm g{WSP(bf16, WS_PB), WSP(const bf16, WS_WP), T, D, PLE}; pg8::StaticOrder S; S.init(T, D, F.G, (int)blockIdx.x);
        pg8::EpiAct<0> E{WSP(bf16, WS_PP), D, nullptr};
        pg8::gemm_phase<pg8::EpiAct<0>, pg8::StaticOrder, true, true>(F.lds, g, S, E, F.wave); } }
    SEAM(4);
    { KArgs ka = kargs_(); F.lane = hw_lane(); F.tid = F.wave * 64 + F.lane; if (IN(5)) {
        pg8::Gemm g{WSP(bf16, WS_MIX), WSP(const bf16, WS_WO), T, D, D}; pg8::StaticOrder S; S.init(T, D, F.G, (int)blockIdx.x);
        pg8::EpiRes E{ka->in[0], ka->out, WSP(bf16, WS_HB), WSP(float, WS_SSQ1)};
        pg8::gemm_phase<pg8::EpiRes, pg8::StaticOrder, true, true>(F.lds, g, S, E, F.wave); } }
    SEAM(5);
    { KArgs ka = kargs_(); F.lane = hw_lane(); F.tid = F.wave * 64 + F.lane; if (IN(6)) {
        pg8::Gemm g{WSP(bf16, WS_HB), WSP(const bf16, WS_WUP), T, FF, D}; pg8::StaticOrder S; S.init(T, FF, F.G, (int)blockIdx.x);
        pg8::EpiAct<1> E{WSP(bf16, WS_HID), FF, WSP(const float, WS_SSQ1)};
        pg8::gemm_phase<pg8::EpiAct<1>, pg8::StaticOrder, true, true>(F.lds, g, S, E, F.wave); } }
    SEAM(6);
    { KArgs ka = kargs_(); F.lane = hw_lane(); F.tid = F.wave * 64 + F.lane; if (IN(7)) {
        pg8::Gemm g{WSP(bf16, WS_HID), WSP(const bf16, WS_WDN), T, D, FF}; pg8::StaticOrder S; S.init(T, D, F.G, (int)blockIdx.x);
        pg8::EpiRes E{ka->out, ka->out, WSP(bf16, WS_HB), WSP(float, WS_SSQ2)};
        pg8::gemm_phase<pg8::EpiRes, pg8::StaticOrder, true, true>(F.lds, g, S, E, F.wave); } }
    SEAM(7);
    { KArgs ka = kargs_(); F.lane = hw_lane(); F.tid = F.wave * 64 + F.lane; if (IN(8)) {
        pg8::Gemm g{WSP(bf16, WS_HB), WSP(const bf16, WS_WG), T, D, D}; pg8::StaticOrder S; S.init(T, D, F.G, (int)blockIdx.x);
        pg8::EpiGate E{ka->out, WSP(const bf16, WS_PP), WSP(const float, WS_SSQ2), WSP(float, WS_SSQ3)};
        pg8::gemm_phase<pg8::EpiGate, pg8::StaticOrder, true, true>(F.lds, g, S, E, F.wave); } }
    SEAM(8);
    { KArgs ka = kargs_(); F.lane = hw_lane(); F.tid = F.wave * 64 + F.lane; if (IN(9)) final_rows(F, ka->out, WSP(const float, WS_SSQ3), ka->in[16]); }
#undef IN
#undef SEAM
#undef WSP
}

extern "C" void kernel_launch(void* const* d_in, const int* in_sizes, int n_in, void* d_out, int out_size, void* d_ws, size_t ws_size, hipStream_t stream) {
    static int grid = 0;
    if (grid == 0) {
        if (n_in != 17 || out_size != T * D || ws_size < WS_END) { fprintf(stderr, "kernel_launch: unexpected shapes (n_in %d out %d ws %zu)\n", n_in, out_size, ws_size); grid = -1; return; }
        int dev = 0, cus = 0;
        if (hipGetDevice(&dev) != hipSuccess || hipDeviceGetAttribute(&cus, hipDeviceAttributeMultiprocessorCount, dev) != hipSuccess) { grid = -1; return; }
        if (hipFuncSetAttribute((const void*)mk_fwd, hipFuncAttributeMaxDynamicSharedMemorySize, LDS_BYTES) != hipSuccess) { fprintf(stderr, "kernel_launch: hipFuncSetAttribute failed\n"); grid = -1; return; }
        int per_cu = 0;
        if (hipOccupancyMaxActiveBlocksPerMultiprocessor(&per_cu, (const void*)mk_fwd, NWAVES * 64, LDS_BYTES) != hipSuccess || per_cu < 1) fprintf(stderr, "kernel_launch: occupancy query says %d\n", per_cu);
        (void)hipGetLastError();
        grid = cus;
    }
    if (grid < 0) return;
    (void)hipMemsetAsync((char*)d_ws + WS_CTL, 0, CTL_ZERO_BYTES, stream);
    Args a{};
    for (int i = 0; i < 17; ++i) a.in[i] = (const float*)d_in[i];
    a.out = (float*)d_out; a.ws = (unsigned char*)d_ws;
#if MK_N_LAUNCHES == 1
    a.ph_lo = 0; a.ph_hi = N_PHASES; a.li = 0;
    hipLaunchKernelGGL(mk_fwd, dim3(grid), dim3(NWAVES * 64), LDS_BYTES, stream, a);
#else
    for (int li = 0; li < N_PHASES; ++li) { a.ph_lo = li; a.ph_hi = li + 1; a.li = li; hipLaunchKernelGGL(mk_fwd, dim3(grid), dim3(NWAVES * 64), LDS_BYTES, stream, a); }
#endif
}
```
